# Optimizing an MI355X kernel written in HIP

```python
import math
import jax, jax.numpy as jnp
from jax import lax
import numpy as np

D_MODEL = 1024
BATCH = 1
SEQ = 16384
DEPTH = 1

MEM_LEN = 256
HEAD_DIM = 64
MIX_WIDTH = D_MODEL
DA_WIDTH = MIX_WIDTH // 2
SB_WIDTH = MIX_WIDTH - DA_WIDTH
DA_HEADS = DA_WIDTH // (2 * HEAD_DIM)
DA_V = 2 * HEAD_DIM
SB_HEADS = SB_WIDTH // HEAD_DIM
DA_Q_COLS = DA_HEADS * 2 * HEAD_DIM
DA_K_COLS = DA_HEADS * 2 * HEAD_DIM
DA_V_COLS = DA_HEADS * DA_V
SB_COLS = SB_HEADS * HEAD_DIM
IN_COLS = DA_Q_COLS + DA_K_COLS + DA_V_COLS + 3 * SB_COLS
ROT_DIM = HEAD_DIM // 4
ROPE_THETA = 500000.0
X_HEADS = 4
X_HEAD_DIM = D_MODEL // X_HEADS
D_FF = 4 * D_MODEL
Q_BLOCK = 128
EPS = 1e-6

kernel_name = "hybrid_diffattn_stickbreaking_block"


def rms_norm(x, g):
    xf = x.astype(jnp.float32)
    y = xf * lax.rsqrt(jnp.mean(xf * xf, axis=-1, keepdims=True) + EPS)
    return (y * g.astype(jnp.float32)).astype(x.dtype)


def rope_tables(positions, dtype):
    inv_freq = ROPE_THETA ** (-jnp.arange(0, ROT_DIM, 2, dtype=jnp.float32) / ROT_DIM)
    ang = positions.astype(jnp.float32)[..., None] * inv_freq
    return jnp.cos(ang).astype(dtype), jnp.sin(ang).astype(dtype)


def apply_partial_rope(x, cos, sin):
    extra = x.ndim - 3
    c = cos.reshape(cos.shape[:2] + (1,) * extra + cos.shape[-1:])
    s = sin.reshape(sin.shape[:2] + (1,) * extra + sin.shape[-1:])
    half = ROT_DIM // 2
    x1, x2, xp = x[..., :half], x[..., half:ROT_DIM], x[..., ROT_DIM:]
    return jnp.concatenate([x1 * c - x2 * s, x2 * c + x1 * s, xp], axis=-1)


def diff_attention(q, k, v, lam, g_subln, lam_init):
    B, S, H = q.shape[0], q.shape[1], q.shape[2]
    nb = S // Q_BLOCK
    scale = 1.0 / math.sqrt(HEAD_DIM)
    kh = k.transpose(0, 2, 3, 1, 4)
    vh = v.transpose(0, 2, 1, 3).astype(jnp.float32)
    qb = q.transpose(0, 2, 3, 1, 4).reshape(B, H, 2, nb, Q_BLOCK, HEAD_DIM)
    qb = jnp.moveaxis(qb, 3, 0)
    qidx = jnp.arange(S, dtype=jnp.int32).reshape(nb, Q_BLOCK)
    kidx = jnp.arange(S, dtype=jnp.int32)

    def block(args):
        qblk, qi = args
        s = jnp.einsum('bhcqd,bhckd->bhcqk', qblk, kh).astype(jnp.float32) * scale
        mask = kidx[None, :] <= qi[:, None]
        p = jax.nn.softmax(jnp.where(mask, s, -jnp.inf), axis=-1)
        w = p[:, :, 0] - lam * p[:, :, 1]
        return jnp.einsum('bhqk,bhkv->bhqv', w, vh)

    o = lax.map(block, (qb, qidx))
    o = o.transpose(1, 0, 3, 2, 4).reshape(B, S, H, DA_V)
    o = rms_norm(o, g_subln) * (1.0 - lam_init)
    return o.reshape(B, S, H * DA_V)


def stick_breaking_attention(q, k, v):
    B, S, H = q.shape[0], q.shape[1], q.shape[2]
    nb = S // Q_BLOCK
    scale = 1.0 / math.sqrt(HEAD_DIM)
    kh = k.transpose(0, 2, 1, 3)
    vh = v.transpose(0, 2, 1, 3).astype(jnp.float32)
    qb = q.transpose(0, 2, 1, 3).reshape(B, H, nb, Q_BLOCK, HEAD_DIM)
    qb = jnp.moveaxis(qb, 2, 0)
    qidx = jnp.arange(S, dtype=jnp.int32).reshape(nb, Q_BLOCK)
    kidx = jnp.arange(S, dtype=jnp.int32)

    def block(args):
        qblk, qi = args
        z = jnp.einsum('bhqd,bhkd->bhqk', qblk, kh).astype(jnp.float32) * scale
        strict = kidx[None, :] < qi[:, None]
        log_beta = jax.nn.log_sigmoid(z)
        log_1mb = jnp.where(strict, jax.nn.log_sigmoid(-z), 0.0)
        between = lax.cumsum(log_1mb, axis=3, reverse=True) - log_1mb
        a = jnp.exp(jnp.where(strict, log_beta + between, -jnp.inf))
        return jnp.einsum('bhqk,bhkd->bhqd', a, vh)

    o = lax.map(block, (qb, qidx))
    return o.transpose(1, 0, 3, 2, 4).reshape(B, S, H * HEAD_DIM)


def cross_attention(h, memn, w_xq, w_xkv, w_xo):
    B, S, _ = h.shape
    q = (h @ w_xq).reshape(B, S, X_HEADS, X_HEAD_DIM)
    kv = memn @ w_xkv
    k = kv[..., :D_MODEL].reshape(B, MEM_LEN, X_HEADS, X_HEAD_DIM)
    v = kv[..., D_MODEL:].reshape(B, MEM_LEN, X_HEADS, X_HEAD_DIM).astype(jnp.float32)
    s = jnp.einsum('bqhd,bkhd->bhqk', q, k).astype(jnp.float32) / math.sqrt(X_HEAD_DIM)
    p = jax.nn.softmax(s, axis=-1)
    o = jnp.einsum('bhqk,bkhd->bqhd', p, v).reshape(B, S, D_MODEL).astype(h.dtype)
    return o @ w_xo


def setup_inputs(seed: int = 0) -> dict:
    key = jax.random.key(seed)
    ks = jax.random.split(key, 24)
    f32 = jnp.float32

    def w(k, shape, fan_in):
        return jax.random.normal(k, shape, f32) * (fan_in ** -0.5)

    def gain(k, shape):
        return 1.0 + 0.02 * jax.random.normal(k, shape, f32)

    L = DEPTH
    return {
        "x": jax.random.normal(ks[0], (BATCH, SEQ, D_MODEL), f32),
        "mem": jax.random.normal(ks[1], (BATCH, MEM_LEN, D_MODEL), f32),
        "positions": jnp.broadcast_to(jnp.arange(SEQ, dtype=jnp.int32), (BATCH, SEQ)),
        "g_mix": gain(ks[2], (L, D_MODEL)),
        "w_in": w(ks[3], (L, D_MODEL, IN_COLS), D_MODEL),
        "lambda_q1": 0.1 * jax.random.normal(ks[4], (L, HEAD_DIM), f32),
        "lambda_k1": 0.1 * jax.random.normal(ks[5], (L, HEAD_DIM), f32),
        "lambda_q2": 0.1 * jax.random.normal(ks[6], (L, HEAD_DIM), f32),
        "lambda_k2": 0.1 * jax.random.normal(ks[7], (L, HEAD_DIM), f32),
        "g_subln": gain(ks[8], (L, DA_V)),
        "w_out": w(ks[9], (L, MIX_WIDTH, D_MODEL), MIX_WIDTH),
        "g_cross": gain(ks[10], (L, D_MODEL)),
        "g_mem": gain(ks[11], (L, D_MODEL)),
        "w_xq": w(ks[12], (L, D_MODEL, D_MODEL), D_MODEL),
        "w_xkv": w(ks[13], (L, D_MODEL, 2 * D_MODEL), D_MODEL),
        "w_xo": w(ks[14], (L, D_MODEL, D_MODEL), D_MODEL),
        "g_mlp": gain(ks[15], (L, D_MODEL)),
        "w_up": w(ks[16], (L, D_MODEL, D_FF), D_MODEL),
        "w_down": w(ks[17], (L, D_FF, D_MODEL), D_FF),
        "g_final": gain(ks[18], (D_MODEL,)),
    }


def reference(x, mem, positions, g_mix, w_in, lambda_q1, lambda_k1, lambda_q2, lambda_k2,
              g_subln, w_out, g_cross, g_mem, w_xq, w_xkv, w_xo, g_mlp, w_up, w_down,
              g_final):
    B, S, _ = x.shape
    cos, sin = rope_tables(positions, x.dtype)
    h = x
    for l in range(DEPTH):
        lam_init = 0.8 - 0.6 * math.exp(-0.3 * l)
        u = rms_norm(h, g_mix[l]) @ w_in[l]
        o0 = 0
        qa = u[..., o0:o0 + DA_Q_COLS].reshape(B, S, DA_HEADS, 2, HEAD_DIM); o0 += DA_Q_COLS
        ka = u[..., o0:o0 + DA_K_COLS].reshape(B, S, DA_HEADS, 2, HEAD_DIM); o0 += DA_K_COLS
        va = u[..., o0:o0 + DA_V_COLS].reshape(B, S, DA_HEADS, DA_V); o0 += DA_V_COLS
        qs = u[..., o0:o0 + SB_COLS].reshape(B, S, SB_HEADS, HEAD_DIM); o0 += SB_COLS
        ksb = u[..., o0:o0 + SB_COLS].reshape(B, S, SB_HEADS, HEAD_DIM); o0 += SB_COLS
        vs = u[..., o0:o0 + SB_COLS].reshape(B, S, SB_HEADS, HEAD_DIM)
        qa = apply_partial_rope(qa, cos, sin)
        ka = apply_partial_rope(ka, cos, sin)
        lam = (jnp.exp(jnp.sum(lambda_q1[l].astype(jnp.float32) * lambda_k1[l].astype(jnp.float32)))
               - jnp.exp(jnp.sum(lambda_q2[l].astype(jnp.float32) * lambda_k2[l].astype(jnp.float32)))
               + lam_init)
        ya = diff_attention(qa, ka, va, lam, g_subln[l], lam_init)
        yb = stick_breaking_attention(qs, ksb, vs)
        y = jnp.concatenate([ya.astype(h.dtype), yb.astype(h.dtype)], axis=-1)
        h = h + y @ w_out[l]
        h = h + cross_attention(rms_norm(h, g_cross[l]), rms_norm(mem, g_mem[l]),
                                w_xq[l], w_xkv[l], w_xo[l])
        a = jnp.square(jax.nn.relu(rms_norm(h, g_mlp[l]) @ w_up[l]))
        h = h + a @ w_down[l]
    return rms_norm(h, g_final)
```

```cpp
#include <hip/hip_runtime.h>
#include <hip/hip_cooperative_groups.h>
#include <cstdio>
#include <cstdint>
namespace cg = cooperative_groups;
namespace pg8 {
#define PG8_LAS __attribute__((address_space(3)))
typedef unsigned short bf16_t;
typedef short bf16x8 __attribute__((ext_vector_type(8)));
typedef float f32x4 __attribute__((ext_vector_type(4)));
typedef unsigned u32x4 __attribute__((ext_vector_type(4)));
constexpr int BM = 256, BK = 64, HALF = 128, HTB = HALF * BK * 2  , STAGE_BYTES = 8 * HTB, NXCD = 8, WGM = 8;

__host__ __device__ __forceinline__ int lds_byte(int r, int c) { const int st = (r >> 4) * 2 + (c >> 5), rr = r & 15, cc = c & 31, ob = rr * 64 + cc * 2; return st * 1024 + (ob ^ (((ob >> 9) & 1) << 5)); }
__host__ __device__ __forceinline__ void stage_rc(int b, int& R, int& C) { const int st = b / 1024, sb = b % 1024, swz = sb ^ (((sb >> 9) & 1) << 5); R = (st >> 1) * 16 + swz / 64; C = (st & 1) * 32 + (swz % 64) / 2; }
__host__ __device__ __forceinline__ int perm32(int rho) { const int n = rho >> 4, i = rho & 15; return 8 * (i >> 2) + 4 * n + (i & 3); }

struct Unit { int pm, pn; };
struct Gemm { const bf16_t* A; const bf16_t* Bt; int M, N, K, lda, ldb; };

struct StaticOrder {
    int nM, nN, nwg, G, c;
    __host__ __device__ void init(int M, int N, int G_, int c_) { nM = M / BM; nN = N / BM; nwg = nM * nN; G = G_; c = c_; }
    __host__ __device__ bool next(int i, Unit& u) const {
        const long L = (long)i * G + c; if (L >= nwg) return false;
        int wgid = (int)L; { const int q = nwg / NXCD, r = nwg % NXCD, xcd = wgid % NXCD, off = wgid / NXCD; wgid = (xcd < r ? xcd * (q + 1) : r * (q + 1) + (xcd - r) * q) + off; }
        const int nig = WGM * nN, gid = wgid / nig, fm = gid * WGM, gsz = (nM - fm) < WGM ? (nM - fm) : WGM;
        u.pm = fm + ((wgid % nig) % gsz); u.pn = (wgid % nig) / gsz; return true;
    }
    __device__ __forceinline__ void a_ready(const Unit&) const {}
    __device__ __forceinline__ void done(const Unit&) const {}
};

__device__ __forceinline__ unsigned cvt_pk_bf16(float lo, float hi) { unsigned r; asm volatile("v_cvt_pk_bf16_f32 %0, %1, %2" : "=v"(r) : "v"(lo), "v"(hi)); return r; }
typedef float f32x2 __attribute__((ext_vector_type(2)));
template <class Epi, class Sched, bool ALIGN_EPI = false, bool SP2 = false>
__device__ __forceinline__ void gemm_phase(PG8_LAS unsigned char* lds, const Gemm g, const Sched& S, const Epi& E) {
    int tid = threadIdx.x; asm volatile("" : "+v"(tid));
    const int wid = __builtin_amdgcn_readfirstlane(tid >> 6), lane = tid & 63, wr = wid >> 2, wc = wid & 3, fr = lane & 15, fq = lane >> 4;
    const int K = g.K, nt = K / BK;
    unsigned voffA[2], voffB[2];
#pragma unroll
    for (int i = 0; i < 2; ++i) { int R, C; stage_rc(tid * 16 + i * 8192, R, C); const int Rb = Epi::PERM ? ((R & ~31) + perm32(R & 31)) : R;
        voffA[i] = (unsigned)(R * g.lda + C) * 2u; voffB[i] = (unsigned)(Rb * g.ldb + C) * 2u; }
    const size_t kstep = (size_t)(BK * 2);
    const size_t hstepA = (size_t)HALF * g.lda * 2, hstepB = (size_t)HALF * g.ldb * 2;
    const size_t tstepA = 2 * hstepA, tstepB = 2 * hstepB;
    const unsigned ldsw = (unsigned)wid * 1024u;
    const int aoff = lds_byte(wr * 64 + fr, fq * 8), boff = lds_byte(wc * 32 + fr, fq * 8);
#define PG8_SA(b, h) (((b) * 2 + (h)) * HTB)
#define PG8_SB(b, h) ((4 + (b) * 2 + (h)) * HTB)
#define PG8_STAGE(bufoff, gbase, voff) do { _Pragma("unroll") for (int _i = 0; _i < 2; ++_i) \
        __builtin_amdgcn_global_load_lds((const unsigned*)((const char*)(gbase) + (voff)[_i]), (PG8_LAS unsigned*)(lds + (bufoff) + ldsw + _i * 8192), 16, 0, 0); } while (0)
#define PG8_LDA(dst, b, h) do { _Pragma("unroll") for (int m = 0; m < 4; ++m) _Pragma("unroll") for (int k = 0; k < 2; ++k) dst[m][k] = *(const PG8_LAS bf16x8*)(lds + PG8_SA(b, h) + aoff + m * 2048 + k * 1024); } while (0)
#define PG8_LDB(dst, b, h) do { _Pragma("unroll") for (int n = 0; n < 2; ++n) _Pragma("unroll") for (int k = 0; k < 2; ++k) dst[n][k] = *(const PG8_LAS bf16x8*)(lds + PG8_SB(b, h) + boff + n * 2048 + k * 1024); } while (0)
#define PG8_MMA(ai, bj, At, Bt) do { __builtin_amdgcn_s_setprio(1); _Pragma("unroll") for (int m = 0; m < 4; ++m) _Pragma("unroll") for (int n = 0; n < 2; ++n) _Pragma("unroll") for (int k = 0; k < 2; ++k) \
        acc[ai][bj][m][n] = __builtin_amdgcn_mfma_f32_16x16x32_bf16(Bt[n][k], At[m][k], acc[ai][bj][m][n], 0, 0, 0); __builtin_amdgcn_s_setprio(0); } while (0)
#define PG8_WAIT_V(n) asm volatile("s_waitcnt vmcnt(" #n ")" ::: "memory")
#define PG8_WAIT_L(n) asm volatile("s_waitcnt lgkmcnt(" #n ")" ::: "memory")
#define PG8_BAR __builtin_amdgcn_s_barrier()
#define PG8_SCHED __builtin_amdgcn_sched_barrier(0)
    Unit cur, nxt; int ui = 0;
    if (!S.next(0, cur)) return;
    f32x4 acc[2][2][4][2];
#pragma unroll
    for (int a = 0; a < 2; ++a)
#pragma unroll
        for (int b = 0; b < 2; ++b)
#pragma unroll
            for (int m = 0; m < 4; ++m)
#pragma unroll
                for (int n = 0; n < 2; ++n) acc[a][b][m][n] = (f32x4){0.f, 0.f, 0.f, 0.f};
    bf16x8 At[4][2], B0[2][2], B1[2][2];
    const char* cA = (const char*)g.A + (size_t)cur.pm * tstepA; const char* cB = (const char*)g.Bt + (size_t)cur.pn * tstepB;
    S.a_ready(cur);
    if constexpr (SP2) {
        PG8_STAGE(PG8_SB(0, 0), cB, voffB); PG8_STAGE(PG8_SB(0, 1), cB + hstepB, voffB); PG8_STAGE(PG8_SA(0, 0), cA, voffA); PG8_STAGE(PG8_SA(0, 1), cA + hstepA, voffA);
        if (wr == 1) PG8_BAR;
        PG8_WAIT_V(2); PG8_BAR;
        PG8_STAGE(PG8_SB(1, 0), cB + kstep, voffB); PG8_STAGE(PG8_SA(1, 0), cA + kstep, voffA); PG8_STAGE(PG8_SB(1, 1), cB + hstepB + kstep, voffB);
        PG8_WAIT_V(6); PG8_BAR;
    } else {
        PG8_STAGE(PG8_SB(0, 0), cB, voffB); PG8_STAGE(PG8_SA(0, 0), cA, voffA); PG8_STAGE(PG8_SB(0, 1), cB + hstepB, voffB); PG8_STAGE(PG8_SA(0, 1), cA + hstepA, voffA);
        if (wr == 1) PG8_BAR;
        PG8_WAIT_V(4); PG8_BAR;
        PG8_STAGE(PG8_SB(1, 0), cB + kstep, voffB); PG8_STAGE(PG8_SA(1, 0), cA + kstep, voffA); PG8_STAGE(PG8_SB(1, 1), cB + hstepB + kstep, voffB);
        PG8_WAIT_V(6); PG8_BAR;
    }
    for (;;) {
        const bool has_next = S.next(ui + 1, nxt);
        const char* nA = has_next ? (const char*)g.A + (size_t)nxt.pm * tstepA : cA; const char* nB = has_next ? (const char*)g.Bt + (size_t)nxt.pn * tstepB : cB;
        for (int t = 0; t < nt; t += 2) {
            const bool last = (t == nt - 2);
            const char* a1 = cA + (size_t)(t + 1) * kstep;
            const char* a2 = last ? nA : cA + (size_t)(t + 2) * kstep; const char* b2 = last ? nB : cB + (size_t)(t + 2) * kstep;
            const char* a3 = a2 + kstep; const char* b3 = b2 + kstep;
            if (last && has_next) S.a_ready(nxt);
            if constexpr (SP2) {
            PG8_LDB(B0, 0, 0); PG8_LDB(B1, 0, 1); PG8_SCHED; PG8_LDA(At, 0, 0); PG8_STAGE(PG8_SA(1, 1), a1 + hstepA, voffA);
            PG8_WAIT_V(8); PG8_WAIT_L(0); PG8_BAR; PG8_MMA(0, 0, At, B0); PG8_MMA(0, 1, At, B1); PG8_BAR; PG8_SCHED;
            PG8_LDA(At, 0, 1); PG8_STAGE(PG8_SB(0, 0), b2, voffB); PG8_STAGE(PG8_SB(0, 1), b2 + hstepB, voffB); PG8_STAGE(PG8_SA(0, 0), a2, voffA);
            PG8_WAIT_V(8); PG8_WAIT_L(0); PG8_BAR; PG8_MMA(1, 0, At, B0); PG8_MMA(1, 1, At, B1); PG8_BAR; PG8_SCHED;
            PG8_LDB(B0, 1, 0); PG8_LDB(B1, 1, 1); PG8_SCHED; PG8_LDA(At, 1, 0); PG8_STAGE(PG8_SA(0, 1), a2 + hstepA, voffA);
            PG8_WAIT_V(8); PG8_WAIT_L(0); PG8_BAR; PG8_MMA(0, 0, At, B0); PG8_MMA(0, 1, At, B1); PG8_BAR; PG8_SCHED;
            PG8_LDA(At, 1, 1); PG8_STAGE(PG8_SB(1, 0), b3, voffB); PG8_STAGE(PG8_SB(1, 1), b3 + hstepB, voffB); PG8_STAGE(PG8_SA(1, 0), a3, voffA);
            PG8_WAIT_V(8); PG8_WAIT_L(0); PG8_BAR; PG8_MMA(1, 0, At, B0); PG8_MMA(1, 1, At, B1); PG8_BAR; PG8_SCHED;
            } else {
            PG8_LDB(B0, 0, 0); PG8_SCHED; PG8_LDA(At, 0, 0); PG8_STAGE(PG8_SA(1, 1), a1 + hstepA, voffA);
            PG8_WAIT_L(8); PG8_BAR; PG8_WAIT_L(0); PG8_MMA(0, 0, At, B0); PG8_BAR; PG8_SCHED;
            PG8_LDB(B1, 0, 1); PG8_STAGE(PG8_SB(0, 0), b2, voffB);
            PG8_BAR; PG8_WAIT_L(0); PG8_MMA(0, 1, At, B1); PG8_BAR;
            PG8_LDA(At, 0, 1); PG8_STAGE(PG8_SA(0, 0), a2, voffA);
            PG8_BAR; PG8_WAIT_L(0); PG8_MMA(1, 0, At, B0); PG8_BAR; PG8_SCHED;
            PG8_STAGE(PG8_SB(0, 1), b2 + hstepB, voffB);
            PG8_WAIT_V(6); PG8_BAR; PG8_MMA(1, 1, At, B1); PG8_BAR;
            PG8_LDB(B0, 1, 0); PG8_SCHED; PG8_LDA(At, 1, 0); PG8_STAGE(PG8_SA(0, 1), a2 + hstepA, voffA);
            PG8_WAIT_L(8); PG8_BAR; PG8_WAIT_L(0); PG8_MMA(0, 0, At, B0); PG8_BAR; PG8_SCHED;
            PG8_LDB(B1, 1, 1); PG8_STAGE(PG8_SB(1, 0), b3, voffB);
            PG8_BAR; PG8_WAIT_L(0); PG8_MMA(0, 1, At, B1); PG8_BAR;
            PG8_LDA(At, 1, 1); PG8_STAGE(PG8_SA(1, 0), a3, voffA);
            PG8_BAR; PG8_WAIT_L(0); PG8_MMA(1, 0, At, B0); PG8_BAR; PG8_SCHED;
            PG8_STAGE(PG8_SB(1, 1), b3 + hstepB, voffB);
            PG8_WAIT_V(6); PG8_BAR; PG8_MMA(1, 1, At, B1); PG8_BAR;
            }
        }
        if constexpr (ALIGN_EPI) { if (wr == 0) PG8_BAR; }
        if constexpr (!Epi::AFTER_DRAIN) { E(acc, cur, wr, wc, fr, fq); S.done(cur); }
        if (!has_next) break;
#pragma unroll
        for (int a = 0; a < 2; ++a)
#pragma unroll
            for (int b = 0; b < 2; ++b)
#pragma unroll
                for (int m = 0; m < 4; ++m)
#pragma unroll
                    for (int n = 0; n < 2; ++n) acc[a][b][m][n] = (f32x4){0.f, 0.f, 0.f, 0.f};
        cur = nxt; cA = nA; cB = nB; ++ui;
        if constexpr (ALIGN_EPI) { if (wr == 1) PG8_BAR; }
    }
    PG8_WAIT_V(0);
    if constexpr (!ALIGN_EPI) { if (wr == 0) PG8_BAR; }
    PG8_BAR;
    if constexpr (Epi::AFTER_DRAIN) { E.fused(acc, cur, wr, wc, fr, fq, lds, wid, lane); S.done(cur); }
#undef PG8_SA
#undef PG8_SB
#undef PG8_STAGE
#undef PG8_LDA
#undef PG8_LDB
#undef PG8_MMA
#undef PG8_WAIT_V
#undef PG8_WAIT_L
#undef PG8_BAR
#undef PG8_SCHED
}
}

constexpr int SEQ = 16384, DM = 1024, INC = 3072, FF = 4096, MEML = 256;
constexpr float RMS_EPS = 1e-6f;
constexpr float LOG2E = 1.4426950408889634f;
constexpr float LAM_INIT = 0.2f;

#define LAS __attribute__((address_space(3)))
typedef unsigned short bf16;
typedef short bf16x8 __attribute__((ext_vector_type(8)));
typedef float f32x4 __attribute__((ext_vector_type(4)));
typedef float f32x16 __attribute__((ext_vector_type(16)));
typedef unsigned u32x4 __attribute__((ext_vector_type(4)));
typedef unsigned u32x2 __attribute__((ext_vector_type(2)));

constexpr size_t MiB = 1u << 20;
constexpr size_t WS_SSQ1 = 0, WS_SSQ2 = 65536, WS_SSQ3 = 131072, WS_ROPE = 262144;
constexpr size_t WS_MEMN = 1536 * 1024, WS_KV = 2 * MiB, WS_BAR = 3 * MiB, BAR_BYTES = 16384;
constexpr size_t WS_WIN = 4 * MiB, WS_WOUT = 10 * MiB, WS_WXQ = 12 * MiB, WS_WXKV = 14 * MiB, WS_WXO = 18 * MiB, WS_WUP = 20 * MiB, WS_WDN = 28 * MiB, WS_WQK = 36 * MiB, WS_WVO = 38 * MiB;
constexpr size_t WS_XN = 40 * MiB, WS_P = 40 * MiB;
constexpr size_t WS_QD = 72 * MiB, WS_KD = 88 * MiB, WS_QS = 104 * MiB, WS_KS = 120 * MiB, WS_VT = 136 * MiB;
constexpr size_t WS_ACT = 40 * MiB;
constexpr size_t WS_Y = 168 * MiB, WS_H2B = 168 * MiB, WS_H1B = 200 * MiB, WS_END = 232 * MiB;

constexpr int LDS_BYTES = 136 * 1024;

__device__ __forceinline__ unsigned cvtpk(float lo, float hi) { unsigned r; asm volatile("v_cvt_pk_bf16_f32 %0, %1, %2" : "=v"(r) : "v"(lo), "v"(hi)); return r; }
__device__ __forceinline__ unsigned short f2bf(float f) { return (unsigned short)(cvtpk(f, f) & 0xffffu); }
__device__ __forceinline__ float wave_sum(float v) {
#pragma unroll
    for (int o = 1; o < 64; o <<= 1) v += __shfl_xor(v, o);
    return v;
}
__device__ __forceinline__ int crow(int r, int hi) { return (r & 3) + 8 * (r >> 2) + 4 * hi; }

using pg8::Unit;

struct EpiInProj {
    static constexpr bool PERM = true, AFTER_DRAIN = false;
    bf16 *Qd, *Kd, *Qs, *Ks, *Vt; const float2* rope; const float* rstd0;
    __device__ __forceinline__ void operator()(const f32x4 (&acc)[2][2][4][2], const Unit& u, int wr, int wc, int fr, int fq) const {
        const int region = u.pn >> 1;
        const int row0 = u.pm * 256 + wr * 64 + fr;
        if (region == 2 || region == 5) {
            const int vrow0 = (region == 5 ? 512 : 0) + (u.pn & 1) * 256 + wc * 32 + 8 * fq;
#pragma unroll
            for (int ai = 0; ai < 2; ++ai)
#pragma unroll
                for (int m = 0; m < 4; ++m) {
                    const int row = row0 + ai * 128 + m * 16; const int x = row & 15;
                    const int pos = (row & ~15) | (x & 3) | ((x & 4) << 1) | ((x & 8) >> 1);
                    const float rs = rstd0[row];
#pragma unroll
                    for (int bj = 0; bj < 2; ++bj)
#pragma unroll
                        for (int n = 0; n < 2; ++n)
#pragma unroll
                            for (int e = 0; e < 4; ++e) Vt[(size_t)(vrow0 + bj * 128 + 4 * n + e) * SEQ + pos] = f2bf(acc[ai][bj][m][n][e] * rs);
                }
        } else {
            bf16* base = region == 0 ? Qd : region == 1 ? Kd : region == 3 ? Qs : Ks;
            const float sc = region == 0 ? 0.125f * LOG2E : region == 3 ? 0.125f : 1.f;
            const bool rope_on = (region < 2) && ((wc & 1) == 0);
            const int d0 = (wc & 1) * 32 + 8 * fq;
#pragma unroll
            for (int ai = 0; ai < 2; ++ai)
#pragma unroll
                for (int m = 0; m < 4; ++m) {
                    const int row = row0 + ai * 128 + m * 16;
                    const float scr_ = sc * rstd0[row];
#pragma unroll
                    for (int bj = 0; bj < 2; ++bj) {
                        const int head = (u.pn & 1) * 4 + 2 * bj + (wc >> 1);
                        f32x4 v0 = acc[ai][bj][m][0], v1 = acc[ai][bj][m][1];
                        if (rope_on) {
                            f32x4 p0, p1;
#pragma unroll
                            for (int e = 0; e < 4; ++e) { p0[e] = __shfl_xor(v0[e], 16); p1[e] = __shfl_xor(v1[e], 16); }
                            if (fq < 2) {
                                const float sg = fq == 0 ? -1.f : 1.f;
                                const float2* rp = rope + (size_t)row * 8;
#pragma unroll
                                for (int e = 0; e < 4; ++e) {
                                    const float2 c0 = rp[e], c1 = rp[4 + e];
                                    v0[e] = v0[e] * c0.x + sg * p0[e] * c0.y;
                                    v1[e] = v1[e] * c1.x + sg * p1[e] * c1.y;
                                }
                            }
                        }
                        u32x4 w; w.x = cvtpk(v0[0] * scr_, v0[1] * scr_); w.y = cvtpk(v0[2] * scr_, v0[3] * scr_); w.z = cvtpk(v1[0] * scr_, v1[1] * scr_); w.w = cvtpk(v1[2] * scr_, v1[3] * scr_);
                        *(u32x4*)(base + ((size_t)head * SEQ + row) * 64 + d0) = w;
                    }
                }
        }
    }
};

__device__ __forceinline__ f32x4 bf4_to_f32(u32x2 w) { f32x4 r; r[0] = __uint_as_float(w.x << 16); r[1] = __uint_as_float(w.x & 0xffff0000u); r[2] = __uint_as_float(w.y << 16); r[3] = __uint_as_float(w.y & 0xffff0000u); return r; }
template <bool BASE_BF16> struct EpiRes {
    static constexpr bool PERM = false, AFTER_DRAIN = false;
    const void* base; bf16* outb; float* ssq;
    __device__ __forceinline__ void operator()(const f32x4 (&acc)[2][2][4][2], const Unit& u, int wr, int wc, int fr, int fq) const {
        const int col0 = u.pn * 256 + wc * 32 + 4 * fq;
#pragma unroll
        for (int ai = 0; ai < 2; ++ai)
#pragma unroll
            for (int m = 0; m < 4; ++m) {
                const int row = u.pm * 256 + ai * 128 + wr * 64 + m * 16 + fr; const size_t off = (size_t)row * DM + col0; float s = 0.f;
#pragma unroll
                for (int bj = 0; bj < 2; ++bj)
#pragma unroll
                    for (int n = 0; n < 2; ++n) {
                        const f32x4 b = BASE_BF16 ? bf4_to_f32(__builtin_nontemporal_load((const u32x2*)((const bf16*)base + off + bj * 128 + n * 16))) : __builtin_nontemporal_load((const f32x4*)((const float*)base + off + bj * 128 + n * 16));
                        const f32x4 o = b + acc[ai][bj][m][n];
                        s += (o[0] * o[0] + o[1] * o[1]) + (o[2] * o[2] + o[3] * o[3]);
                        u32x2 w; w.x = cvtpk(o[0], o[1]); w.y = cvtpk(o[2], o[3]); *(u32x2*)(outb + off + bj * 128 + n * 16) = w;
                    }
                s += __shfl_xor(s, 16); s += __shfl_xor(s, 32);
                if (fq == 0) atomicAdd(ssq + row, s);
            }
    }
};

struct EpiResF32 {
    static constexpr bool PERM = false, AFTER_DRAIN = false;
    const bf16* base; float* out; float* ssq;
    __device__ __forceinline__ void operator()(const f32x4 (&acc)[2][2][4][2], const Unit& u, int wr, int wc, int fr, int fq) const {
        const int col0 = u.pn * 256 + wc * 32 + 4 * fq;
#pragma unroll
        for (int ai = 0; ai < 2; ++ai)
#pragma unroll
            for (int m = 0; m < 4; ++m) {
                const int row = u.pm * 256 + ai * 128 + wr * 64 + m * 16 + fr; const size_t off = (size_t)row * DM + col0; float s = 0.f;
#pragma unroll
                for (int bj = 0; bj < 2; ++bj)
#pragma unroll
                    for (int n = 0; n < 2; ++n) {
                        const f32x4 o = bf4_to_f32(*(const u32x2*)(base + off + bj * 128 + n * 16)) + acc[ai][bj][m][n];
                        *(f32x4*)(out + off + bj * 128 + n * 16) = o; s += (o[0] * o[0] + o[1] * o[1]) + (o[2] * o[2] + o[3] * o[3]);
                    }
                s += __shfl_xor(s, 16); s += __shfl_xor(s, 32);
                if (fq == 0) atomicAdd(ssq + row, s);
            }
    }
};

struct EpiPlain {
    static constexpr bool PERM = true, AFTER_DRAIN = false;
    bf16* O; int ldc, row_off, col_off; const float* colscale; float scale;
    __device__ __forceinline__ void operator()(const f32x4 (&acc)[2][2][4][2], const Unit& u, int wr, int wc, int fr, int fq) const {
#pragma unroll
        for (int bj = 0; bj < 2; ++bj) {
            const int col = u.pn * 256 + bj * 128 + wc * 32 + 8 * fq;
            f32x4 c0 = (f32x4){scale, scale, scale, scale}, c1 = c0;
            if (colscale) { c0 = *(const f32x4*)(colscale + col) * scale; c1 = *(const f32x4*)(colscale + col + 4) * scale; }
#pragma unroll
            for (int ai = 0; ai < 2; ++ai)
#pragma unroll
                for (int m = 0; m < 4; ++m) {
                    const int row = row_off + u.pm * 256 + ai * 128 + wr * 64 + m * 16 + fr;
                    const f32x4 v0 = acc[ai][bj][m][0] * c0, v1 = acc[ai][bj][m][1] * c1;
                    u32x4 w; w.x = cvtpk(v0[0], v0[1]); w.y = cvtpk(v0[2], v0[3]); w.z = cvtpk(v1[0], v1[1]); w.w = cvtpk(v1[2], v1[3]);
                    *(u32x4*)(O + (size_t)row * ldc + col_off + col) = w;
                }
        }
    }
};

struct EpiUp {
    static constexpr bool PERM = true, AFTER_DRAIN = false;
    const float* ssq; bf16* O;
    __device__ __forceinline__ void operator()(const f32x4 (&acc)[2][2][4][2], const Unit& u, int wr, int wc, int fr, int fq) const {
#pragma unroll
        for (int ai = 0; ai < 2; ++ai)
#pragma unroll
            for (int m = 0; m < 4; ++m) {
                const int row = u.pm * 256 + ai * 128 + wr * 64 + m * 16 + fr;
                const float rstd = 1.0f / sqrtf(ssq[row] * (1.0f / DM) + RMS_EPS);
#pragma unroll
                for (int bj = 0; bj < 2; ++bj) {
                    f32x4 v0 = acc[ai][bj][m][0] * rstd, v1 = acc[ai][bj][m][1] * rstd;
#pragma unroll
                    for (int e = 0; e < 4; ++e) { const float a = fmaxf(v0[e], 0.f), b = fmaxf(v1[e], 0.f); v0[e] = a * a; v1[e] = b * b; }
                    u32x4 w; w.x = cvtpk(v0[0], v0[1]); w.y = cvtpk(v0[2], v0[3]); w.z = cvtpk(v1[0], v1[1]); w.w = cvtpk(v1[2], v1[3]);
                    *(u32x4*)(O + (size_t)row * FF + u.pn * 256 + bj * 128 + wc * 32 + 8 * fq) = w;
                }
            }
    }
};

struct EpiCrossSoftmax {
    static constexpr bool PERM = true, AFTER_DRAIN = true;
    const float* ssq; bf16* P;
    __device__ __forceinline__ void fused(f32x4 (&acc)[2][2][4][2], const Unit& u, int wr, int wc, int fr, int fq, LAS unsigned char* lds, int wid, int lane) const {
        LAS float* Pm = (LAS float*)lds; LAS float* Ps = (LAS float*)(lds + 4096);
#pragma unroll
        for (int ai = 0; ai < 2; ++ai)
#pragma unroll
            for (int m = 0; m < 4; ++m) {
                const int r = ai * 128 + wr * 64 + m * 16 + fr;
                const float rstd = LOG2E / sqrtf(ssq[u.pm * 256 + r] * (1.0f / DM) + RMS_EPS);
                float mx = -3.0e38f;
#pragma unroll
                for (int bj = 0; bj < 2; ++bj)
#pragma unroll
                    for (int n = 0; n < 2; ++n)
#pragma unroll
                        for (int e = 0; e < 4; ++e) { const float v = acc[ai][bj][m][n][e] * rstd; acc[ai][bj][m][n][e] = v; mx = fmaxf(mx, v); }
                mx = fmaxf(mx, __shfl_xor(mx, 16)); mx = fmaxf(mx, __shfl_xor(mx, 32));
                if (fq == 0) Pm[r * 4 + wc] = mx;
            }
        __syncthreads();
#pragma unroll
        for (int ai = 0; ai < 2; ++ai)
#pragma unroll
            for (int m = 0; m < 4; ++m) {
                const int r = ai * 128 + wr * 64 + m * 16 + fr;
                const f32x4 pm = *(const LAS f32x4*)(Pm + r * 4);
                const float M = fmaxf(fmaxf(pm[0], pm[1]), fmaxf(pm[2], pm[3]));
                float s = 0.f;
#pragma unroll
                for (int bj = 0; bj < 2; ++bj)
#pragma unroll
                    for (int n = 0; n < 2; ++n)
#pragma unroll
                        for (int e = 0; e < 4; ++e) { const float p = __builtin_amdgcn_exp2f(acc[ai][bj][m][n][e] - M); acc[ai][bj][m][n][e] = p; s += p; }
                s += __shfl_xor(s, 16); s += __shfl_xor(s, 32);
                if (fq == 0) Ps[r * 4 + wc] = s;
            }
        __syncthreads();
#pragma unroll
        for (int ai = 0; ai < 2; ++ai)
#pragma unroll
            for (int m = 0; m < 4; ++m) {
                const int r = ai * 128 + wr * 64 + m * 16 + fr;
                const f32x4 ps = *(const LAS f32x4*)(Ps + r * 4);
                const float inv = 1.0f / ((ps[0] + ps[1]) + (ps[2] + ps[3]));
#pragma unroll
                for (int bj = 0; bj < 2; ++bj) {
                    const f32x4 v0 = acc[ai][bj][m][0] * inv, v1 = acc[ai][bj][m][1] * inv;
                    u32x4 w; w.x = cvtpk(v0[0], v0[1]); w.y = cvtpk(v0[2], v0[3]); w.z = cvtpk(v1[0], v1[1]); w.w = cvtpk(v1[2], v1[3]);
                    *(u32x4*)(P + (size_t)(u.pm * 256 + r) * DM + u.pn * 256 + bj * 128 + wc * 32 + 8 * fq) = w;
                }
            }
        __syncthreads();
    }
};

struct EpiResFinal {
    static constexpr bool PERM = false, AFTER_DRAIN = true;
    const bf16* base; float* out; float* ssq; unsigned* cnt; const float* gfin;
    __device__ __forceinline__ void fused(f32x4 (&acc)[2][2][4][2], const Unit& u, int wr, int wc, int fr, int fq, LAS unsigned char* lds, int wid, int lane) const {
        const int col0 = u.pn * 256 + wc * 32 + 4 * fq;
#pragma unroll
        for (int ai = 0; ai < 2; ++ai)
#pragma unroll
            for (int m = 0; m < 4; ++m) {
                const int row = u.pm * 256 + ai * 128 + wr * 64 + m * 16 + fr; const size_t off = (size_t)row * DM + col0; float s = 0.f;
#pragma unroll
                for (int bj = 0; bj < 2; ++bj)
#pragma unroll
                    for (int n = 0; n < 2; ++n) {
                        const f32x4 b = bf4_to_f32(*(const u32x2*)(base + off + bj * 128 + n * 16)); const f32x4 o = b + acc[ai][bj][m][n];
                        acc[ai][bj][m][n] = o; s += (o[0] * o[0] + o[1] * o[1]) + (o[2] * o[2] + o[3] * o[3]);
                    }
                s += __shfl_xor(s, 16); s += __shfl_xor(s, 32);
                if (fq == 0) atomicAdd(ssq + row, s);
            }
        asm volatile("s_waitcnt vmcnt(0)" ::: "memory");
        __syncthreads();
        if (threadIdx.x == 0) {
            __builtin_amdgcn_fence(__ATOMIC_RELEASE, "agent");
            asm volatile("s_waitcnt vmcnt(0)" ::: "memory");
            __hip_atomic_fetch_add(cnt + u.pm, 1u, __ATOMIC_RELAXED, __HIP_MEMORY_SCOPE_AGENT);
            unsigned sp = 0;
            while (__hip_atomic_load(cnt + u.pm, __ATOMIC_RELAXED, __HIP_MEMORY_SCOPE_AGENT) < 4u) { __builtin_amdgcn_s_sleep(1); if (++sp > (1u << 22)) break; }
            __builtin_amdgcn_fence(__ATOMIC_ACQUIRE, "agent");
        }
        __syncthreads();
#pragma unroll
        for (int ai = 0; ai < 2; ++ai)
#pragma unroll
            for (int m = 0; m < 4; ++m) {
                const int row = u.pm * 256 + ai * 128 + wr * 64 + m * 16 + fr; const size_t off = (size_t)row * DM + col0;
                const float rstd = 1.0f / sqrtf(__hip_atomic_load(ssq + row, __ATOMIC_RELAXED, __HIP_MEMORY_SCOPE_AGENT) * (1.0f / DM) + RMS_EPS);
#pragma unroll
                for (int bj = 0; bj < 2; ++bj)
#pragma unroll
                    for (int n = 0; n < 2; ++n) {
                        const f32x4 g = *(const f32x4*)(gfin + col0 + bj * 128 + n * 16);
                        *(f32x4*)(out + off + bj * 128 + n * 16) = acc[ai][bj][m][n] * rstd * g;
                    }
            }
    }
};

struct SmallOrder {
    int c0, nN, n, c;
    __device__ __forceinline__ bool next(int i, Unit& u) const { if (i) return false; const int L = c - c0; if (L < 0 || L >= n) return false; u.pm = L / nN; u.pn = L % nN; return true; }
    __device__ __forceinline__ void a_ready(const Unit&) const {}
    __device__ __forceinline__ void done(const Unit&) const {}
};

__device__ __forceinline__ void p0_transpose_item(const float* W, int K, int N, bf16* WT, const float* gain, LAS float* scr, int item, int lane) {
    const int nblk = N / 32, kb = item / nblk, nb = item % nblk, k0 = 64 * kb, n0 = 32 * nb;
#pragma unroll
    for (int i = 0; i < 8; ++i) {
        const int kk = 8 * i + (lane >> 3), nn = 4 * (lane & 7);
        f32x4 v = __builtin_nontemporal_load((const f32x4*)(W + (size_t)(k0 + kk) * N + n0 + nn)); if (gain) v = v * gain[k0 + kk];
        LAS float* d = scr + kk * 33 + nn; d[0] = v[0]; d[1] = v[1]; d[2] = v[2]; d[3] = v[3];
    }
    asm volatile("s_waitcnt lgkmcnt(0)" ::: "memory");
    const int c = lane & 7;
#pragma unroll
    for (int j = 0; j < 4; ++j) { const int n = (lane >> 3) + 8 * j; const LAS float* s = scr + (8 * c) * 33 + n;
        u32x4 o; o.x = cvtpk(s[0 * 33], s[1 * 33]); o.y = cvtpk(s[2 * 33], s[3 * 33]); o.z = cvtpk(s[4 * 33], s[5 * 33]); o.w = cvtpk(s[6 * 33], s[7 * 33]);
        *(u32x4*)(WT + (size_t)(n0 + n) * K + k0 + 8 * c) = o; }
    asm volatile("s_waitcnt lgkmcnt(0)" ::: "memory");
}
__device__ __forceinline__ void rms_row_to_bf16(const float* xrow, const float* g, bf16* orow, int lane) {
    const f32x4* xr = (const f32x4*)xrow + lane; const f32x4* gr = (const f32x4*)g + lane;
    f32x4 v[4]; float s = 0.f;
#pragma unroll
    for (int j = 0; j < 4; ++j) { v[j] = __builtin_nontemporal_load(xr + 64 * j); s += (v[j][0] * v[j][0] + v[j][1] * v[j][1]) + (v[j][2] * v[j][2] + v[j][3] * v[j][3]); }
    const float rstd = 1.0f / sqrtf(wave_sum(s) * (1.0f / DM) + RMS_EPS);
    u32x2* o8 = (u32x2*)orow + lane;
#pragma unroll
    for (int j = 0; j < 4; ++j) { const f32x4 gg = gr[64 * j]; u32x2 w; w.x = cvtpk(v[j][0] * rstd * gg[0], v[j][1] * rstd * gg[1]); w.y = cvtpk(v[j][2] * rstd * gg[2], v[j][3] * rstd * gg[3]); o8[64 * j] = w; }
}

__device__ __forceinline__ void row_to_bf16_rstd(const float* xrow, bf16* orow, float* rstd_out, int lane) {
    const f32x4* xr = (const f32x4*)xrow + lane;
    f32x4 v[4]; float s = 0.f;
#pragma unroll
    for (int j = 0; j < 4; ++j) { v[j] = __builtin_nontemporal_load(xr + 64 * j); s += (v[j][0] * v[j][0] + v[j][1] * v[j][1]) + (v[j][2] * v[j][2] + v[j][3] * v[j][3]); }
    s = wave_sum(s);
    if (lane == 0) *rstd_out = 1.0f / sqrtf(s * (1.0f / DM) + RMS_EPS);
    u32x2* o8 = (u32x2*)orow + lane;
#pragma unroll
    for (int j = 0; j < 4; ++j) { u32x2 w; w.x = cvtpk(v[j][0], v[j][1]); w.y = cvtpk(v[j][2], v[j][3]); o8[64 * j] = w; }
}

__device__ __forceinline__ void sb_wave_unit(int head, int qsub, const bf16* Qs, const bf16* Ks, const bf16* Vt, bf16* Y, int lane) {
    const int r32 = lane & 31, hi = lane >> 5;
    const int t0 = qsub * 32;
    const bf16* qp = Qs + ((size_t)head * SEQ + t0 + r32) * 64 + 8 * hi;
    bf16x8 qf[4];
#pragma unroll
    for (int s = 0; s < 4; ++s) qf[s] = *(const bf16x8*)(qp + 16 * s);
    f32x16 o0 = {}, o1 = {};
    float C = 0.f;
    const bf16* kbase = Ks + (size_t)head * SEQ * 64 + (size_t)r32 * 64 + 8 * hi;
    const bf16* vbase = Vt + (size_t)(512 + head * 64 + r32) * SEQ + 8 * hi;
    for (int kv0 = t0; kv0 >= 0; kv0 -= 32) {
        bf16x8 kf[4], vf0[2], vf1[2];
#pragma unroll
        for (int s = 0; s < 4; ++s) kf[s] = *(const bf16x8*)(kbase + (size_t)kv0 * 64 + 16 * s);
#pragma unroll
        for (int s = 0; s < 2; ++s) { vf0[s] = *(const bf16x8*)(vbase + kv0 + 16 * s); vf1[s] = *(const bf16x8*)(vbase + (size_t)32 * SEQ + kv0 + 16 * s); }
        f32x16 z = {};
#pragma unroll
        for (int s = 0; s < 4; ++s) z = __builtin_amdgcn_mfma_f32_32x32x16_bf16(kf[s], qf[s], z, 0, 0, 0);
        const bool diag = (kv0 == t0);
        float lm[16], sn[16];
#pragma unroll
        for (int r = 0; r < 16; ++r) {
            const float zz = z[r];
            const float e = __expf(-fabsf(zz));
            const float lp = __logf(1.0f + e);
            const bool valid = (!diag) || (crow(r, hi) < r32);
            lm[r] = valid ? -(fmaxf(zz, 0.f) + lp) : 0.f;
            sn[r] = valid ? (fmaxf(-zz, 0.f) + lp) : 1.0e30f;
        }
        float gs[4], ot[4], T[4];
#pragma unroll
        for (int G = 0; G < 4; ++G) { gs[G] = (lm[4 * G] + lm[4 * G + 1]) + (lm[4 * G + 2] + lm[4 * G + 3]); ot[G] = __shfl_xor(gs[G], 32); T[G] = gs[G] + ot[G]; }
        float sfx[4]; sfx[3] = 0.f; sfx[2] = T[3]; sfx[1] = T[3] + T[2]; sfx[0] = T[3] + T[2] + T[1];
        float a[16];
#pragma unroll
        for (int G = 0; G < 4; ++G) {
            const float off = C + sfx[G] + (hi == 0 ? ot[G] : 0.f);
            const float w2 = lm[4 * G + 3], w1 = w2 + lm[4 * G + 2], w0 = w1 + lm[4 * G + 1];
            a[4 * G + 3] = __expf(off - sn[4 * G + 3]);
            a[4 * G + 2] = __expf(off + w2 - sn[4 * G + 2]);
            a[4 * G + 1] = __expf(off + w1 - sn[4 * G + 1]);
            a[4 * G + 0] = __expf(off + w0 - sn[4 * G + 0]);
        }
        C += (T[0] + T[1]) + (T[2] + T[3]);
        u32x4 p0, p1;
        p0.x = cvtpk(a[0], a[1]); p0.y = cvtpk(a[2], a[3]); p0.z = cvtpk(a[4], a[5]); p0.w = cvtpk(a[6], a[7]);
        p1.x = cvtpk(a[8], a[9]); p1.y = cvtpk(a[10], a[11]); p1.z = cvtpk(a[12], a[13]); p1.w = cvtpk(a[14], a[15]);
        const bf16x8 pf0 = __builtin_bit_cast(bf16x8, p0), pf1 = __builtin_bit_cast(bf16x8, p1);
        o0 = __builtin_amdgcn_mfma_f32_32x32x16_bf16(vf0[0], pf0, o0, 0, 0, 0);
        o0 = __builtin_amdgcn_mfma_f32_32x32x16_bf16(vf0[1], pf1, o0, 0, 0, 0);
        o1 = __builtin_amdgcn_mfma_f32_32x32x16_bf16(vf1[0], pf0, o1, 0, 0, 0);
        o1 = __builtin_amdgcn_mfma_f32_32x32x16_bf16(vf1[1], pf1, o1, 0, 0, 0);
        if (__all(C < -100.0f)) break;
    }
    bf16* yp = Y + (size_t)(t0 + r32) * DM + 512 + head * 64 + 4 * hi;
#pragma unroll
    for (int g = 0; g < 4; ++g) {
        u32x2 w0, w1;
        w0.x = cvtpk(o0[4 * g], o0[4 * g + 1]); w0.y = cvtpk(o0[4 * g + 2], o0[4 * g + 3]);
        w1.x = cvtpk(o1[4 * g], o1[4 * g + 1]); w1.y = cvtpk(o1[4 * g + 2], o1[4 * g + 3]);
        *(u32x2*)(yp + 8 * g) = w0; *(u32x2*)(yp + 32 + 8 * g) = w1;
    }
}

constexpr int DA_PITCH = 128, DA_KB = 64 * DA_PITCH, DA_KBUF = 2 * DA_KB, DA_VB = 128 * DA_PITCH, DA_NSLOT = 3, DA_VOFF = DA_NSLOT * DA_KBUF, DA_QOFF = DA_VOFF + DA_NSLOT * DA_VB;
__device__ __forceinline__ float max3f(float a, float b, float c) { float r; asm volatile("v_max3_f32 %0, %1, %2, %3" : "=v"(r) : "v"(a), "v"(b), "v"(c)); return r; }
__device__ __forceinline__ float da_rowmax(f32x16& a, f32x16& b) {
    asm volatile("s_nop 15\n\ts_nop 7" : "+v"(a), "+v"(b));
    float m0 = max3f(a[0], a[1], a[2]), m1 = max3f(b[0], b[1], b[2]);
#pragma unroll
    for (int r = 3; r < 15; r += 2) { m0 = max3f(m0, a[r], a[r + 1]); m1 = max3f(m1, b[r], b[r + 1]); }
    float m = max3f(m0, m1, a[15]); m = max3f(m, b[15], b[15]);
    const auto rr = __builtin_amdgcn_permlane32_swap(__float_as_uint(m), __float_as_uint(m), false, false);
    return fmaxf(__uint_as_float(rr[0]), __uint_as_float(rr[1]));
}
__device__ __forceinline__ void da_mask(f32x16& s0, f32x16& s1, int kv0, int qrow, int hi) {
#pragma unroll
    for (int r = 0; r < 16; ++r) { const int kv = kv0 + crow(r, hi); if (kv > qrow) s0[r] = -1.0e30f; if (kv + 32 > qrow) s1[r] = -1.0e30f; }
}
template <bool DO_QK, bool DO_PV>
__device__ __forceinline__ void da_core(f32x16 (&o)[4], f32x16& s0, f32x16& s1, f32x16& n0, f32x16& n1, const f32x16& negm, const u32x4 (&pp)[4], float& l,
                                        const LAS unsigned char* qb, LAS unsigned char* kt, LAS unsigned char* vt, const int (&xo)[4]) {
    if (DO_QK) {
#pragma unroll
        for (int s = 0; s < 4; ++s) {
            const bf16x8 ka = *(const LAS bf16x8*)(kt + xo[s]), kb = *(const LAS bf16x8*)(kt + 32 * DA_PITCH + xo[s]);
            const bf16x8 qv = *(const LAS bf16x8*)(qb + s * 1024);
            n0 = __builtin_amdgcn_mfma_f32_32x32x16_bf16(ka, qv, s == 0 ? negm : n0, 0, 0, 0); n1 = __builtin_amdgcn_mfma_f32_32x32x16_bf16(kb, qv, s == 0 ? negm : n1, 0, 0, 0);
        }
    }
    if (DO_PV) {
#pragma unroll
        for (int db = 0; db < 4; ++db)
#pragma unroll
            for (int s = 0; s < 4; ++s) {
                const bf16x8 va = *(const LAS bf16x8*)(vt + db * 32 * DA_PITCH + xo[s]);
                o[db] = __builtin_amdgcn_mfma_f32_32x32x16_bf16(va, __builtin_bit_cast(bf16x8, pp[s]), o[db], 0, 0, 0);
            }
    }
    float ps = 0.f;
#pragma unroll
    for (int r = 0; r < 16; ++r) { s0[r] = __builtin_amdgcn_exp2f(s0[r]); s1[r] = __builtin_amdgcn_exp2f(s1[r]); ps += s0[r] + s1[r]; }
    l += ps;
}
struct DaDma { const bf16 *k0, *k1, *v0, *v1; size_t ko, vo; LAS unsigned char *kd, *vd; };
template <bool DMA_IN>
__device__ __forceinline__ void da_core_mid(f32x16 (&o)[4], f32x16& s0, f32x16& s1, f32x16& n0, f32x16& n1, const f32x16& negm, const u32x4 (&pp)[4], float& l,
                                            const LAS unsigned char* qb, LAS unsigned char* kt, LAS unsigned char* vt, const int (&xo)[4], float& mpart, const DaDma& dm) {
    bf16x8 fa[24], fq[4];
    float ps = 0.f, m0 = 0.f, m1 = 0.f;
#define DA_RD(j) do { if ((j) < 8) { fa[(j)] = *(const LAS bf16x8*)(kt + ((j) & 1) * 32 * DA_PITCH + xo[((j) >> 1) & 3]); if (((j) & 1) == 0) fq[((j) >> 1) & 3] = *(const LAS bf16x8*)(qb + (((j) >> 1) & 3) * 1024); } \
                      else { fa[(j)] = *(const LAS bf16x8*)(vt + (((j) - 8) & 3) * 32 * DA_PITCH + xo[(((j) - 8) >> 2) & 3]); } } while (0)
#define DA_EX(k) do { float a_; if ((k) & 1) { a_ = __builtin_amdgcn_exp2f(s1[(k) >> 1]); asm volatile("" : "+v"(a_)); s1[(k) >> 1] = a_; } else { a_ = __builtin_amdgcn_exp2f(s0[(k) >> 1]); asm volatile("" : "+v"(a_)); s0[(k) >> 1] = a_; } } while (0)
#define DA_AD(k) do { ps += ((k) & 1) ? s1[(k) >> 1] : s0[(k) >> 1]; } while (0)
    DA_RD(0); DA_RD(1); DA_RD(2); DA_RD(3);
    __builtin_amdgcn_s_setprio(1);
    __builtin_amdgcn_sched_barrier(0);
#pragma unroll
    for (int j = 0; j < 24; ++j) {
        if ((j & 3) == 0 && j + 4 < 24) { DA_RD(j + 4); DA_RD(j + 5); DA_RD(j + 6); DA_RD(j + 7); __builtin_amdgcn_sched_barrier(0); }
        if (j < 8) {
            const int sq = j >> 1;
            if ((j & 1) == 0) n0 = __builtin_amdgcn_mfma_f32_32x32x16_bf16(fa[j], fq[sq], sq == 0 ? negm : n0, 0, 0, 0);
            else              n1 = __builtin_amdgcn_mfma_f32_32x32x16_bf16(fa[j], fq[sq], sq == 0 ? negm : n1, 0, 0, 0);
        } else {
            const int sv = (j - 8) >> 2, db = (j - 8) & 3;
            o[db] = __builtin_amdgcn_mfma_f32_32x32x16_bf16(fa[j], __builtin_bit_cast(bf16x8, pp[sv]), o[db], 0, 0, 0);
        }
        const int k0 = (4 * j) / 3, k1 = (4 * (j + 1)) / 3;
#pragma unroll
        for (int k = 0; k < 32; ++k) if (k >= k0 && k < k1) DA_EX(k);
        if (j > 0) { const int a0 = (4 * (j - 1)) / 3, a1 = (4 * j) / 3;
#pragma unroll
            for (int k = 0; k < 32; ++k) if (k >= a0 && k < a1) DA_AD(k);
            asm volatile("" : "+v"(ps)); }
        if (DMA_IN) {
            if (j >= 1 && j <= 4) {
                const bf16* p = (j == 1) ? dm.k0 + dm.ko : (j == 2) ? dm.k1 + dm.ko : (j == 3) ? dm.v0 + dm.vo : dm.v1 + dm.vo;
                asm volatile("" : "+v"(p));
                LAS unsigned char* d = (j == 1) ? dm.kd : (j == 2) ? dm.kd + DA_KB : (j == 3) ? dm.vd : dm.vd + 8192;
                __builtin_amdgcn_global_load_lds((const unsigned*)p, (LAS unsigned*)d, 16, 0, 0);
            }
        }
        if (j == 12) { m0 = max3f(n0[0], n0[1], n0[2]); m1 = max3f(n1[0], n1[1], n1[2]); }
        if (j >= 13 && j <= 18) { const int r = 3 + 2 * (j - 13); m0 = max3f(m0, n0[r], n0[r + 1]); m1 = max3f(m1, n1[r], n1[r + 1]); }
        if (j == 19) { m0 = max3f(m0, m1, n0[15]); m0 = max3f(m0, n1[15], n1[15]); }
        __builtin_amdgcn_sched_barrier(0);
    }
    __builtin_amdgcn_s_setprio(0);
    mpart = m0;
    DA_AD(30); DA_AD(31);
#undef DA_RD
#undef DA_EX
#undef DA_AD
    l += ps;
}
__device__ __forceinline__ void da_pack(u32x4 (&pp)[4], const f32x16& s0, const f32x16& s1) {
    pp[0].x = cvtpk(s0[0], s0[1]); pp[0].y = cvtpk(s0[2], s0[3]); pp[0].z = cvtpk(s0[4], s0[5]); pp[0].w = cvtpk(s0[6], s0[7]);
    pp[1].x = cvtpk(s0[8], s0[9]); pp[1].y = cvtpk(s0[10], s0[11]); pp[1].z = cvtpk(s0[12], s0[13]); pp[1].w = cvtpk(s0[14], s0[15]);
    pp[2].x = cvtpk(s1[0], s1[1]); pp[2].y = cvtpk(s1[2], s1[3]); pp[2].z = cvtpk(s1[4], s1[5]); pp[2].w = cvtpk(s1[6], s1[7]);
    pp[3].x = cvtpk(s1[8], s1[9]); pp[3].y = cvtpk(s1[10], s1[11]); pp[3].z = cvtpk(s1[12], s1[13]); pp[3].w = cvtpk(s1[14], s1[15]);
}
__device__ __forceinline__ void da_tail(f32x16 (&o)[4], f32x16& s0, f32x16& s1, f32x16& n0, f32x16& n1, f32x16& negm, float& l, bool boundary, int kv0n, int qrow, int hi, bool have_part = false, float mpart = 0.f) {
    float mt;
    if (boundary || !have_part) { if (boundary) da_mask(n0, n1, kv0n, qrow, hi); mt = da_rowmax(n0, n1); }
    else { const auto rr = __builtin_amdgcn_permlane32_swap(__float_as_uint(mpart), __float_as_uint(mpart), false, false); mt = fmaxf(__uint_as_float(rr[0]), __uint_as_float(rr[1])); }
    if (__any(mt > 8.0f)) {
        const float d = fmaxf(mt, 0.f), alpha = __builtin_amdgcn_exp2f(-d);
#pragma unroll
        for (int r = 0; r < 16; ++r) { n0[r] -= d; n1[r] -= d; negm[r] -= d; s0[r] *= alpha; s1[r] *= alpha; }
#pragma unroll
        for (int db = 0; db < 4; ++db) o[db] *= alpha;
        l *= alpha;
        asm volatile("" : "+v"(negm));
    }
}
__device__ __forceinline__ void diff_unit(int h, int qb, const bf16* Qd, const bf16* Kd, const bf16* Vt, bf16* Y, const float* g_subln, float lam, LAS unsigned char* lds) {
    int tid = threadIdx.x; asm volatile("" : "+v"(tid));
    const int lane = tid & 63, wave = __builtin_amdgcn_readfirstlane(tid >> 6), r32 = lane & 31, hi = lane >> 5;
    const int comp = wave >> 2, wq = wave & 3;
    const int q0 = qb * 128, qrow = q0 + wq * 32 + r32;
    const bf16* qp = Qd + ((size_t)(2 * h + comp) * SEQ + qrow) * 64 + 8 * hi;
    LAS unsigned char* qfb = lds + DA_QOFF + wave * 4096 + lane * 16;
#pragma unroll
    for (int s = 0; s < 4; ++s) *(LAS bf16x8*)(qfb + s * 1024) = *(const bf16x8*)(qp + 16 * s);
    const int NT = (q0 + 128) / 64;
    const int prow = lane >> 3, pch = (lane & 7) ^ ((4 * wave + (lane >> 4)) & 7);
    const bf16* gk0 = Kd + ((size_t)(2 * h) * SEQ + 8 * wave + prow) * 64 + pch * 8;
    const bf16* gk1 = Kd + ((size_t)(2 * h + 1) * SEQ + 8 * wave + prow) * 64 + pch * 8;
    const bf16* gv0 = Vt + (size_t)(h * 128 + 8 * wave + prow) * SEQ + pch * 8;
    const bf16* gv1 = Vt + (size_t)(h * 128 + 64 + 8 * wave + prow) * SEQ + pch * 8;
    LAS unsigned char* ldw = lds + wave * 1024;
#define DA_DMA(gp, dst) __builtin_amdgcn_global_load_lds((const unsigned*)(gp), (LAS unsigned*)(dst), 16, 0, 0)
#define DA_WAITBAR() do { asm volatile("s_waitcnt vmcnt(0) lgkmcnt(0)" ::: "memory"); __builtin_amdgcn_s_barrier(); asm volatile("" ::: "memory"); } while (0)
    int xo[4];
#pragma unroll
    for (int s = 0; s < 4; ++s) xo[s] = ((2 * s + hi) ^ ((r32 >> 1) & 7)) * 16;
    LAS unsigned char* kfrag = lds + comp * DA_KB + r32 * DA_PITCH;
    LAS unsigned char* vfrag = lds + DA_VOFF + r32 * DA_PITCH;
#define DA_WAITBAR_N(N) do { asm volatile("s_waitcnt vmcnt(" #N ") lgkmcnt(0)" ::: "memory"); __builtin_amdgcn_s_barrier(); asm volatile("" ::: "memory"); } while (0)
    DA_DMA(gk0, ldw); DA_DMA(gk1, ldw + DA_KB); DA_DMA(gk0 + 64 * 64, ldw + DA_KBUF); DA_DMA(gk1 + 64 * 64, ldw + DA_KBUF + DA_KB);
    if (2 < NT) { DA_DMA(gk0 + (size_t)2 * 64 * 64, ldw + 2 * DA_KBUF); DA_DMA(gk1 + (size_t)2 * 64 * 64, ldw + 2 * DA_KBUF + DA_KB); }
    DA_DMA(gv0, ldw + DA_VOFF); DA_DMA(gv1, ldw + DA_VOFF + 8192);
    if (2 < NT) DA_WAITBAR_N(4); else DA_WAITBAR_N(2);
    f32x16 o[4]; o[0] = f32x16{}; o[1] = f32x16{}; o[2] = f32x16{}; o[3] = f32x16{};
    f32x16 s0, s1, n0 = {}, n1 = {}, negm = {};
    u32x4 pp[4] = {};
    float l = 0.f;
    {
        da_core<true, false>(o, n0, n1, s0, s1, negm, pp, l, qfb, kfrag, vfrag, xo);
        if (NT == 2) da_mask(s0, s1, 0, qrow, hi);
        const float m0 = da_rowmax(s0, s1);
#pragma unroll
        for (int r = 0; r < 16; ++r) { s0[r] -= m0; s1[r] -= m0; negm[r] = -m0; }
        asm volatile("" : "+v"(negm));
        l = 0.f;
    }
    int ks1 = DA_KBUF, ks3 = 0, vsm = 2 * DA_VB, vs1 = DA_VB;
#define DA_ROT() do { ks3 = ks1; ks1 = (ks1 == 2 * DA_KBUF) ? 0 : ks1 + DA_KBUF; vsm = (vsm == 2 * DA_VB) ? 0 : vsm + DA_VB; vs1 = (vs1 == 2 * DA_VB) ? 0 : vs1 + DA_VB; } while (0)
    {
        int nd = 0;
        asm volatile("s_waitcnt lgkmcnt(0)" ::: "memory"); __builtin_amdgcn_s_barrier(); asm volatile("" ::: "memory");
        if (3 < NT) { DA_DMA(gk0 + (size_t)3 * 64 * 64, ldw + ks3); DA_DMA(gk1 + (size_t)3 * 64 * 64, ldw + ks3 + DA_KB); nd += 2; }
        DA_DMA(gv0 + 64, ldw + DA_VOFF + vs1); DA_DMA(gv1 + 64, ldw + DA_VOFF + vs1 + 8192); nd += 2;
        da_core<true, false>(o, s0, s1, n0, n1, negm, pp, l, qfb, kfrag + ks1, vfrag, xo);
        da_tail(o, s0, s1, n0, n1, negm, l, 1 >= NT - 2, 64, qrow, hi);
        da_pack(pp, s0, s1); s0 = n0; s1 = n1;
        if (nd == 4) DA_WAITBAR_N(4); else DA_WAITBAR_N(2);
        DA_ROT();
    }
    int t = 1;
    for (; t + 4 < NT; t += 2) {
        {
            const size_t ko = (size_t)(t + 3) * 64 * 64;
            const DaDma dm{gk0, gk1, gv0, gv1, ko, (size_t)(t + 1) * 64, ldw + ks3, ldw + DA_VOFF + vs1};
            float mp;
            da_core_mid<true>(o, s0, s1, n0, n1, negm, pp, l, qfb, kfrag + ks1, vfrag + vsm, xo, mp, dm);
            da_tail(o, s0, s1, n0, n1, negm, l, false, 0, qrow, hi, true, mp);
            da_pack(pp, s0, s1);
            DA_WAITBAR_N(4);
            DA_ROT();
        }
        {
            const int u = t + 1;
            const size_t ko = (size_t)(u + 3) * 64 * 64;
            const DaDma dm{gk0, gk1, gv0, gv1, ko, (size_t)(u + 1) * 64, ldw + ks3, ldw + DA_VOFF + vs1};
            float mp;
            da_core_mid<true>(o, n0, n1, s0, s1, negm, pp, l, qfb, kfrag + ks1, vfrag + vsm, xo, mp, dm);
            da_tail(o, n0, n1, s0, s1, negm, l, false, 0, qrow, hi, true, mp);
            da_pack(pp, n0, n1);
            DA_WAITBAR_N(4);
            DA_ROT();
        }
    }
    for (; t < NT - 1; t += 2) {
        {
            int nd = 0;
            if (t + 3 < NT) { const size_t ko = (size_t)(t + 3) * 64 * 64; DA_DMA(gk0 + ko, ldw + ks3); DA_DMA(gk1 + ko, ldw + ks3 + DA_KB); nd += 2; }
            if (t + 1 < NT) { DA_DMA(gv0 + (size_t)(t + 1) * 64, ldw + DA_VOFF + vs1); DA_DMA(gv1 + (size_t)(t + 1) * 64, ldw + DA_VOFF + vs1 + 8192); nd += 2; }
            float mp;
            da_core_mid<false>(o, s0, s1, n0, n1, negm, pp, l, qfb, kfrag + ks1, vfrag + vsm, xo, mp, DaDma{});
            da_tail(o, s0, s1, n0, n1, negm, l, t + 1 >= NT - 2, (t + 1) * 64, qrow, hi, true, mp);
            da_pack(pp, s0, s1);
            if (nd == 4) DA_WAITBAR_N(4); else if (nd == 2) DA_WAITBAR_N(2); else DA_WAITBAR_N(0);
            DA_ROT();
        }
        {
            const int u = t + 1;
            int nd = 0;
            if (u + 3 < NT) { const size_t ko = (size_t)(u + 3) * 64 * 64; DA_DMA(gk0 + ko, ldw + ks3); DA_DMA(gk1 + ko, ldw + ks3 + DA_KB); nd += 2; }
            if (u + 1 < NT) { DA_DMA(gv0 + (size_t)(u + 1) * 64, ldw + DA_VOFF + vs1); DA_DMA(gv1 + (size_t)(u + 1) * 64, ldw + DA_VOFF + vs1 + 8192); nd += 2; }
            float mp;
            da_core_mid<false>(o, n0, n1, s0, s1, negm, pp, l, qfb, kfrag + ks1, vfrag + vsm, xo, mp, DaDma{});
            da_tail(o, n0, n1, s0, s1, negm, l, u + 1 >= NT - 2, (u + 1) * 64, qrow, hi, true, mp);
            da_pack(pp, n0, n1);
            if (nd == 4) DA_WAITBAR_N(4); else if (nd == 2) DA_WAITBAR_N(2); else DA_WAITBAR_N(0);
            DA_ROT();
        }
    }
    {
        da_core<false, true>(o, s0, s1, n0, n1, negm, pp, l, qfb, kfrag, vfrag + vsm, xo);
        da_pack(pp, s0, s1);
        DA_WAITBAR_N(0);
        const int vsl = (vsm == 2 * DA_VB) ? 0 : vsm + DA_VB;
        LAS unsigned char* vt = vfrag + vsl;
#pragma unroll
        for (int db = 0; db < 4; ++db)
#pragma unroll
            for (int s = 0; s < 4; ++s) {
                const bf16x8 va = *(const LAS bf16x8*)(vt + db * 32 * DA_PITCH + xo[s]);
                o[db] = __builtin_amdgcn_mfma_f32_32x32x16_bf16(va, __builtin_bit_cast(bf16x8, pp[s]), o[db], 0, 0, 0);
            }
    }
#undef DA_ROT
#undef DA_WAITBAR_N
#undef DA_DMA
    l += __shfl_xor(l, 32);
    const float inv = 1.0f / l;
    __syncthreads();
    LAS float* xb = (LAS float*)lds + (size_t)wq * 4096 + lane;
    if (comp == 1) {
#pragma unroll
        for (int db = 0; db < 4; ++db)
#pragma unroll
            for (int r = 0; r < 16; ++r) xb[(db * 16 + r) * 64] = o[db][r] * inv;
    }
    __syncthreads();
    if (comp == 0) {
        float ssq = 0.f;
#pragma unroll
        for (int db = 0; db < 4; ++db)
#pragma unroll
            for (int r = 0; r < 16; ++r) { const float d = o[db][r] * inv - lam * xb[(db * 16 + r) * 64]; o[db][r] = d; ssq += d * d; }
        ssq += __shfl_xor(ssq, 32);
        const float rstd = (1.0f - LAM_INIT) / sqrtf(ssq * (1.0f / 128.0f) + RMS_EPS);
        bf16* yp = Y + (size_t)qrow * DM + h * 128 + 4 * hi;
#pragma unroll
        for (int db = 0; db < 4; ++db)
#pragma unroll
            for (int g = 0; g < 4; ++g) {
                const f32x4 gg = *(const f32x4*)(g_subln + db * 32 + 8 * g + 4 * hi);
                u32x2 w; w.x = cvtpk(o[db][4 * g] * rstd * gg[0], o[db][4 * g + 1] * rstd * gg[1]); w.y = cvtpk(o[db][4 * g + 2] * rstd * gg[2], o[db][4 * g + 3] * rstd * gg[3]);
                *(u32x2*)(yp + db * 32 + 8 * g) = w;
            }
    }
    __syncthreads();
}

#define XB_TMO      128
#define XB_XCNT(j)  (256  + 64 * (j))
#define XB_XSUB(j)  (1280 + 64 * (j))
#define XB_XGEN(j)  (2304 + 64 * (j))
#define XB_TOP      3328
#define XB_TOPGEN   3392
#define XCD_BAR_WORDS 3456
#define XB_SPIN_CAP (1u << 18)

__device__ __forceinline__ unsigned xb_ld(unsigned* p)              { return __hip_atomic_load(p, __ATOMIC_RELAXED, __HIP_MEMORY_SCOPE_AGENT); }
__device__ __forceinline__ unsigned xb_add(unsigned* p, unsigned v) { return __hip_atomic_fetch_add(p, v, __ATOMIC_RELAXED, __HIP_MEMORY_SCOPE_AGENT); }
__device__ __forceinline__ unsigned xb_xcc_id() { return (unsigned)__builtin_amdgcn_s_getreg((3 << 11) | 20) & 0xFu; }
#define XB_SPIN(cond, bar) do { unsigned _sp = 0; while (cond) { __builtin_amdgcn_s_sleep(1); \
    if ((++_sp & 255u) == 0u) { if (xb_ld(&(bar)[XB_TMO])) break; if (_sp > XB_SPIN_CAP) { atomicAdd(&(bar)[XB_TMO], 1u); break; } } } } while (0)

struct XcdBarrier {
    unsigned* bar; unsigned x;
    volatile LAS unsigned* st;
};

__device__ __forceinline__ XcdBarrier xcd_barrier_post(unsigned* bar, volatile LAS unsigned* st) {
    XcdBarrier b; b.bar = bar; b.x = xb_xcc_id(); b.st = st;
    if (threadIdx.x == 0) (void)xb_add(&bar[XB_XCNT(b.x)], 1u);
    return b;
}
__device__ __forceinline__ void xcd_barrier_complete(unsigned* bar, unsigned x, unsigned& nloc, unsigned& nx) {
    const unsigned G = gridDim.x * gridDim.y * gridDim.z;
    unsigned sum, cnt, mine, sp = 0u;
    for (;;) {
        sum = 0u; cnt = 0u; mine = 0u;
#pragma unroll
        for (unsigned j = 0; j < 16; ++j) { const unsigned c = xb_ld(&bar[XB_XCNT(j)]); sum += c; cnt += (c > 0u) ? 1u : 0u; mine = (j == x) ? c : mine; }
        if (sum == G) break;
        __builtin_amdgcn_s_sleep(1);
        if ((++sp & 255u) == 0u) { if (xb_ld(&bar[XB_TMO])) break; if (sp > XB_SPIN_CAP) { atomicAdd(&bar[XB_TMO], 1u); break; } }
    }
    nloc = mine > 0u ? mine : 1u; nx = cnt > 0u ? cnt : 1u;
}

__device__ __forceinline__ void xcd_barrier(const XcdBarrier& b) {
    asm volatile("s_waitcnt vmcnt(0)" ::: "memory");
    __syncthreads();
    if (threadIdx.x == 0) {
        unsigned* bar = b.bar;
        __builtin_amdgcn_s_waitcnt(0);
        unsigned nloc = b.st[0], nx = b.st[1];
        if (nloc == 0u) { xcd_barrier_complete(bar, b.x, nloc, nx); b.st[0] = nloc; b.st[1] = nx; }
        const unsigned old = xb_add(&bar[XB_XSUB(b.x)], 1u);
        const unsigned gen = old / nloc;
        if (old + 1u == (gen + 1u) * nloc) {
            __builtin_amdgcn_fence(__ATOMIC_RELEASE, "agent");
            asm volatile("s_waitcnt vmcnt(0)" ::: "memory");
            const unsigned og = xb_add(&bar[XB_TOP], 1u);
            const unsigned tg = og / nx;
            if (og + 1u == (tg + 1u) * nx) xb_add(&bar[XB_TOPGEN], 1u);
            else XB_SPIN(xb_ld(&bar[XB_TOPGEN]) == tg, bar);
            __builtin_amdgcn_fence(__ATOMIC_ACQUIRE, "agent");
            xb_add(&bar[XB_XGEN(b.x)], 1u);
            asm volatile("s_waitcnt vmcnt(0)" ::: "memory");
        } else {
            XB_SPIN(xb_ld(&bar[XB_XGEN(b.x)]) == gen, bar);
            __builtin_amdgcn_fence(__ATOMIC_ACQUIRE, "agent");
            asm volatile("s_waitcnt vmcnt(0)" ::: "memory");
        }
    }
    __syncthreads();
}

#ifndef MK_N_LAUNCHES
#define MK_N_LAUNCHES 1
#endif
constexpr int N_PHASES = 9;
struct Args { const void* in[20]; float* out; unsigned char* ws; int ph_lo, ph_hi; };

__global__ void __launch_bounds__(512, 2) mega_fwd(Args args) {
    extern __shared__ __attribute__((aligned(16))) unsigned char lds_raw[];
    LAS unsigned char* lds = (LAS unsigned char*)lds_raw;
    cg::grid_group grid = cg::this_grid();
    const int G = gridDim.x, bx = blockIdx.x, NGW = G * 8;
#define PHASE_IDS int tid = threadIdx.x; asm volatile("" : "+v"(tid)); const int lane = tid & 63, wave = __builtin_amdgcn_readfirstlane(tid >> 6), gw = bx * 8 + wave; (void)lane; (void)gw;
    unsigned char* ws = args.ws;
    const float* x = (const float*)args.in[0]; const float* mem = (const float*)args.in[1]; const int* positions = (const int*)args.in[2];
    const float* g_mix = (const float*)args.in[3]; const float* w_in = (const float*)args.in[4];
    const float* lq1 = (const float*)args.in[5]; const float* lk1 = (const float*)args.in[6]; const float* lq2 = (const float*)args.in[7]; const float* lk2 = (const float*)args.in[8];
    const float* g_subln = (const float*)args.in[9]; const float* w_out = (const float*)args.in[10]; const float* g_cross = (const float*)args.in[11]; const float* g_mem = (const float*)args.in[12];
    const float* w_xq = (const float*)args.in[13]; const float* w_xkv = (const float*)args.in[14]; const float* w_xo = (const float*)args.in[15]; const float* g_mlp = (const float*)args.in[16];
    const float* w_up = (const float*)args.in[17]; const float* w_down = (const float*)args.in[18]; const float* g_final = (const float*)args.in[19];
    float* out = args.out;
    float* rstd0 = (float*)(ws + 196608); float* ssq1 = (float*)(ws + WS_SSQ1); float* ssq2 = (float*)(ws + WS_SSQ2); float* ssq3 = (float*)(ws + WS_SSQ3);
    float2* rope = (float2*)(ws + WS_ROPE);
    bf16* memn = (bf16*)(ws + WS_MEMN); bf16* kvb = (bf16*)(ws + WS_KV);
    bf16* Win_t = (bf16*)(ws + WS_WIN); bf16* Wout_t = (bf16*)(ws + WS_WOUT); bf16* Wxq_b = (bf16*)(ws + WS_WXQ); bf16* Wxkv_t = (bf16*)(ws + WS_WXKV); bf16* Wxo_t = (bf16*)(ws + WS_WXO);
    bf16* Wup_t = (bf16*)(ws + WS_WUP); bf16* Wdn_t = (bf16*)(ws + WS_WDN); bf16* Wqk_t = (bf16*)(ws + WS_WQK); bf16* Wvo_t = (bf16*)(ws + WS_WVO);
    bf16* XN = (bf16*)(ws + WS_XN); bf16* Pb = (bf16*)(ws + WS_P);
    bf16* Qd = (bf16*)(ws + WS_QD); bf16* Kd = (bf16*)(ws + WS_KD); bf16* Qs = (bf16*)(ws + WS_QS); bf16* Ks = (bf16*)(ws + WS_KS); bf16* Vt = (bf16*)(ws + WS_VT);
    bf16* Act = (bf16*)(ws + WS_ACT); bf16* Yb = (bf16*)(ws + WS_Y); bf16* H2b = (bf16*)(ws + WS_H2B); bf16* H1b = (bf16*)(ws + WS_H1B);

    const int lo = args.ph_lo, hi_ = args.ph_hi;
#define IN(k) (lo <= (k) && (k) < hi_)
    volatile LAS unsigned* bst = (volatile LAS unsigned*)(lds + 132096);
    if (threadIdx.x < 2) bst[threadIdx.x] = 0u;
    __syncthreads();
    XcdBarrier bar = xcd_barrier_post((unsigned*)(ws + WS_BAR), bst);
    if (lo < 0) grid.sync();
#define SEAM(k) do { if (IN(k) && IN((k) + 1)) xcd_barrier(bar); } while (0)

    if (IN(0)) {
        PHASE_IDS
        LAS float* scr = (LAS float*)(lds + wave * 16384);
        constexpr int I_IN = 16 * 96, I_OUT = 16 * 32, I_XKV = 16 * 64, I_XO = 16 * 32, I_UP = 16 * 128, I_DN = 64 * 32;
        for (int it = gw; it < I_XKV; it += NGW) p0_transpose_item(w_xkv, DM, 2 * DM, Wxkv_t, nullptr, scr, it, lane);
        for (int m = gw; m < MEML; m += NGW) rms_row_to_bf16(mem + (size_t)m * DM, g_mem, memn + (size_t)m * DM, lane);
        xcd_barrier(bar);
        const int NB = (G > 8) ? G - 8 : G;
        if (G > 8 && bx >= NB) {
            pg8::Gemm g{memn, Wxkv_t, MEML, 2 * DM, DM, DM, DM}; SmallOrder S{NB, 8, 8, bx};
            EpiPlain E{kvb, 2 * DM, 0, 0, nullptr, 1.0f};
            pg8::gemm_phase<EpiPlain, SmallOrder, true, true>(lds, g, S, E);
        }
        if (bx < NB) {
            const int gwl = bx * 8 + wave, NGWL = NB * 8;
            constexpr int NITEMS = I_IN + I_OUT + I_XO;
            for (int it = gwl; it < NITEMS; it += NGWL) {
                int r = it;
                if (r < I_IN) { p0_transpose_item(w_in, DM, INC, Win_t, g_mix, scr, r, lane); continue; } r -= I_IN;
                if (r < I_OUT) { p0_transpose_item(w_out, DM, DM, Wout_t, nullptr, scr, r, lane); continue; } r -= I_OUT;
                p0_transpose_item(w_xo, DM, DM, Wxo_t, nullptr, scr, r, lane);
            }
            const int gt = bx * 512 + tid, NGT = NB * 512;
            for (int i = gt; i < DM * DM / 4; i += NGT) { const f32x4 v = __builtin_nontemporal_load((const f32x4*)w_xq + i); u32x2 w; w.x = cvtpk(v[0], v[1]); w.y = cvtpk(v[2], v[3]); ((u32x2*)Wxq_b)[i] = w; }
            for (int i = gt; i < SEQ * 8; i += NGT) {
                const int row = i >> 3, k = i & 7;
                const float inv_freq = (float)pow(500000.0, -(double)k / 8.0);
                const float ang = (float)positions[row] * inv_freq;
                rope[i] = make_float2((float)cos((double)ang), (float)sin((double)ang));
            }
            for (int i = gt; i < SEQ; i += NGT) { ssq1[i] = 0.f; ssq2[i] = 0.f; ssq3[i] = 0.f; }
            for (int m = gwl; m < SEQ; m += NGWL) row_to_bf16_rstd(x + (size_t)m * DM, XN + (size_t)m * DM, rstd0 + m, lane);
        }
    }
    SEAM(0);
    if (IN(1)) {
        pg8::Gemm g{XN, Win_t, SEQ, INC, DM, DM, DM}; pg8::StaticOrder S; S.init(SEQ, INC, G, bx);
        EpiInProj E{Qd, Kd, Qs, Ks, Vt, rope, rstd0};
        pg8::gemm_phase<EpiInProj, pg8::StaticOrder, true, true>(lds, g, S, E);
    }
    SEAM(1);
    if (IN(2)) {
        PHASE_IDS
#pragma unroll 1
        for (int j = 0; j < 8; ++j) {
            const int hh = j & 3; const bool qk = j < 4;
            pg8::Gemm g{qk ? kvb + hh * 256 : Wxo_t + hh * 256, qk ? Wxq_b + hh * 256 : kvb + DM + hh * 256, qk ? 256 : DM, qk ? DM : 256, 256, qk ? 2 * DM : DM, qk ? DM : 2 * DM};
            SmallOrder S{4 * j, qk ? 4 : 1, 4, bx};
            EpiPlain E{qk ? Wqk_t : Wvo_t, DM, qk ? hh * 256 : 0, qk ? 0 : hh * 256, qk ? g_cross : nullptr, qk ? 0.0625f : 1.0f};
            pg8::gemm_phase<EpiPlain, SmallOrder, true, true>(lds, g, S, E);
        }
        for (int uu = gw; uu < 8 * (SEQ / 32); uu += NGW) sb_wave_unit(uu & 7, uu >> 3, Qs, Ks, Vt, Yb, lane);
        float lam;
        { const float a = wave_sum(lq1[lane] * lk1[lane]), b = wave_sum(lq2[lane] * lk2[lane]); lam = expf(a) - expf(b) + LAM_INIT; }
        __syncthreads();
        for (int p = bx; p < 256; p += G) {
            const int h = p & 3, pp = p >> 2;
#pragma unroll 1
            for (int k = 0; k < 2; ++k) diff_unit(h, k ? pp : 127 - pp, Qd, Kd, Vt, Yb, g_subln, lam, lds);
        }
        {
            const int nb0 = (G > 32) ? 32 : 0;
            if (bx >= nb0) {
                PHASE_IDS
                constexpr int I_UP = 16 * 128, I_DN = 64 * 32;
                LAS float* scr = (LAS float*)(lds + wave * 16384);
#pragma unroll 1
                for (int it = (bx - nb0) * 8 + wave; it < I_UP + I_DN; it += (G - nb0) * 8) {
                    const bool up = it < I_UP;
                    p0_transpose_item(up ? w_up : w_down, up ? DM : FF, up ? FF : DM, up ? Wup_t : Wdn_t, up ? g_mlp : nullptr, scr, up ? it : it - I_UP, lane);
                }
            }
        }
    }
    SEAM(2);
    if (IN(3)) {
        pg8::Gemm g{Yb, Wout_t, SEQ, DM, DM, DM, DM}; pg8::StaticOrder S; S.init(SEQ, DM, G, bx);
        EpiRes<true> E{XN, H1b, ssq1};
        pg8::gemm_phase<EpiRes<true>, pg8::StaticOrder, true, true>(lds, g, S, E);
    }
    SEAM(3);
    if (IN(4)) {
        pg8::Gemm g{H1b, Wqk_t, SEQ, DM, DM, DM, DM}; pg8::StaticOrder S; S.init(SEQ, DM, G, bx);
        EpiCrossSoftmax E{ssq1, Pb};
        pg8::gemm_phase<EpiCrossSoftmax, pg8::StaticOrder, false, true>(lds, g, S, E);
    }
    SEAM(4);
    if (IN(5)) {
        pg8::Gemm g{Pb, Wvo_t, SEQ, DM, DM, DM, DM}; pg8::StaticOrder S; S.init(SEQ, DM, G, bx);
        EpiRes<true> E{H1b, H2b, ssq2};
        pg8::gemm_phase<EpiRes<true>, pg8::StaticOrder, true, true>(lds, g, S, E);
    }
    SEAM(5);
    if (IN(6)) {
        pg8::Gemm g{H2b, Wup_t, SEQ, FF, DM, DM, DM}; pg8::StaticOrder S; S.init(SEQ, FF, G, bx);
        EpiUp E{ssq2, Act};
        pg8::gemm_phase<EpiUp, pg8::StaticOrder, true, true>(lds, g, S, E);
    }
    SEAM(6);
    const bool fuse_final = (G == 256);
    if (IN(7)) {
        pg8::Gemm g{Act, Wdn_t, SEQ, DM, FF, FF, FF}; pg8::StaticOrder S; S.init(SEQ, DM, G, bx);
        if (fuse_final) {
            EpiResFinal E{H2b, out, ssq3, (unsigned*)(ws + WS_BAR + 14336), g_final};
            pg8::gemm_phase<EpiResFinal, pg8::StaticOrder, false, true>(lds, g, S, E);
        } else {
            EpiResF32 E{H2b, out, ssq3};
            pg8::gemm_phase<EpiResF32, pg8::StaticOrder, true, true>(lds, g, S, E);
        }
    }
    if (!fuse_final) {
        SEAM(7);
        if (IN(8)) {
            PHASE_IDS
            for (int m = gw; m < SEQ; m += NGW) {
                const float rstd = 1.0f / sqrtf(ssq3[m] * (1.0f / DM) + RMS_EPS);
                f32x4* orow = (f32x4*)(out + (size_t)m * DM) + lane; const f32x4* gr = (const f32x4*)g_final + lane;
#pragma unroll
                for (int j = 0; j < 4; ++j) { const f32x4 v = orow[64 * j]; orow[64 * j] = v * rstd * gr[64 * j]; }
            }
        }
    }
#undef IN
#undef SEAM
}

extern "C" void kernel_launch(void* const* d_in, const int* in_sizes, int n_in, void* d_out, int out_size, void* d_ws, size_t ws_size, hipStream_t stream) {
    static int grid = 0;
    if (grid == 0) {
        if (n_in != 20 || out_size != SEQ * DM || ws_size < WS_END) { fprintf(stderr, "kernel_launch: unexpected shapes (n_in %d out %d ws %zu)\n", n_in, out_size, ws_size); grid = -1; return; }
        int dev = 0, cus = 0, per_cu = 0;
        (void)hipGetDevice(&dev); (void)hipDeviceGetAttribute(&cus, hipDeviceAttributeMultiprocessorCount, dev);
        if (hipFuncSetAttribute((const void*)mega_fwd, hipFuncAttributeMaxDynamicSharedMemorySize, LDS_BYTES) != hipSuccess) { fprintf(stderr, "kernel_launch: hipFuncSetAttribute failed\n"); grid = -1; return; }
        if (hipOccupancyMaxActiveBlocksPerMultiprocessor(&per_cu, (const void*)mega_fwd, 512, LDS_BYTES) != hipSuccess || per_cu < 1) per_cu = 1;
        (void)hipGetLastError();
        grid = cus * per_cu;
        fprintf(stderr, "kernel_launch: grid %d (cus %d x %d)\n", grid, cus, per_cu);
    }
    if (grid < 0) return;
    Args a{};
    for (int i = 0; i < 20; ++i) a.in[i] = d_in[i];
    a.out = (float*)d_out; a.ws = (unsigned char*)d_ws;
#if MK_N_LAUNCHES == 1
    if (hipMemsetAsync((char*)d_ws + WS_BAR, 0, BAR_BYTES, stream) != hipSuccess) { fprintf(stderr, "kernel_launch: hipMemsetAsync failed\n"); return; }
    a.ph_lo = 0; a.ph_hi = N_PHASES;
    void* kargs[] = {&a};
    hipError_t e = hipLaunchCooperativeKernel((const void*)mega_fwd, dim3(grid), dim3(512), kargs, LDS_BYTES, stream);
    if (e != hipSuccess) fprintf(stderr, "cooperative launch failed: %s (grid %d)\n", hipGetErrorString(e), grid);
#else
    for (int p = 0; p < N_PHASES; ++p) { a.ph_lo = p; a.ph_hi = p + 1; hipLaunchKernelGGL(mega_fwd, dim3(grid), dim3(512), LDS_BYTES, stream, a); }
#endif
}
```

```cpp
#include <hip/hip_runtime.h>
#include <hip/hip_cooperative_groups.h>
#include <cstdio>
#include <cstdint>
namespace cg = cooperative_groups;
namespace pg8 {
#define PG8_LAS __attribute__((address_space(3)))
typedef unsigned short bf16_t;
typedef short bf16x8 __attribute__((ext_vector_type(8)));
typedef float f32x4 __attribute__((ext_vector_type(4)));
typedef unsigned u32x4 __attribute__((ext_vector_type(4)));
constexpr int BM = 256, BK = 64, HALF = 128, HTB = HALF * BK * 2  , STAGE_BYTES = 8 * HTB, NXCD = 8, WGM = 8;

__host__ __device__ __forceinline__ int lds_byte(int r, int c) { const int st = (r >> 4) * 2 + (c >> 5), rr = r & 15, cc = c & 31, ob = rr * 64 + cc * 2; return st * 1024 + (ob ^ (((ob >> 9) & 1) << 5)); }
__host__ __device__ __forceinline__ void stage_rc(int b, int& R, int& C) { const int st = b / 1024, sb = b % 1024, swz = sb ^ (((sb >> 9) & 1) << 5); R = (st >> 1) * 16 + swz / 64; C = (st & 1) * 32 + (swz % 64) / 2; }
__host__ __device__ __forceinline__ int perm32(int rho) { const int n = rho >> 4, i = rho & 15; return 8 * (i >> 2) + 4 * n + (i & 3); }

struct Unit { int pm, pn; };
struct Gemm { const bf16_t* A; const bf16_t* Bt; int M, N, K, lda, ldb; };

struct StaticOrder {
    int nM, nN, nwg, G, c;
    __host__ __device__ void init(int M, int N, int G_, int c_) { nM = M / BM; nN = N / BM; nwg = nM * nN; G = G_; c = c_; }
    __host__ __device__ bool next(int i, Unit& u) const {
        const long L = (long)i * G + c; if (L >= nwg) return false;
        int wgid = (int)L; { const int q = nwg / NXCD, r = nwg % NXCD, xcd = wgid % NXCD, off = wgid / NXCD; wgid = (xcd < r ? xcd * (q + 1) : r * (q + 1) + (xcd - r) * q) + off; }
        const int nig = WGM * nN, gid = wgid / nig, fm = gid * WGM, gsz = (nM - fm) < WGM ? (nM - fm) : WGM;
        u.pm = fm + ((wgid % nig) % gsz); u.pn = (wgid % nig) / gsz; return true;
    }
    __device__ __forceinline__ void a_ready(const Unit&) const {}
    __device__ __forceinline__ void done(const Unit&) const {}
};

__device__ __forceinline__ unsigned cvt_pk_bf16(float lo, float hi) { unsigned r; asm volatile("v_cvt_pk_bf16_f32 %0, %1, %2" : "=v"(r) : "v"(lo), "v"(hi)); return r; }
typedef float f32x2 __attribute__((ext_vector_type(2)));
template <class Epi, class Sched, bool ALIGN_EPI = false, bool SP2 = false>
__device__ __forceinline__ void gemm_phase(PG8_LAS unsigned char* lds, const Gemm g, const Sched& S, const Epi& E) {
    int tid = threadIdx.x; asm volatile("" : "+v"(tid));
    const int wid = __builtin_amdgcn_readfirstlane(tid >> 6), lane = tid & 63, wr = wid >> 2, wc = wid & 3, fr = lane & 15, fq = lane >> 4;
    const int K = g.K, nt = K / BK;
    unsigned voffA[2], voffB[2];
#pragma unroll
    for (int i = 0; i < 2; ++i) { int R, C; stage_rc(tid * 16 + i * 8192, R, C); const int Rb = Epi::PERM ? ((R & ~31) + perm32(R & 31)) : R;
        voffA[i] = (unsigned)(R * g.lda + C) * 2u; voffB[i] = (unsigned)(Rb * g.ldb + C) * 2u; }
    const size_t kstep = (size_t)(BK * 2);
    const size_t hstepA = (size_t)HALF * g.lda * 2, hstepB = (size_t)HALF * g.ldb * 2;
    const size_t tstepA = 2 * hstepA, tstepB = 2 * hstepB;
    const unsigned ldsw = (unsigned)wid * 1024u;
    const int aoff = lds_byte(wr * 64 + fr, fq * 8), boff = lds_byte(wc * 32 + fr, fq * 8);
#define PG8_SA(b, h) (((b) * 2 + (h)) * HTB)
#define PG8_SB(b, h) ((4 + (b) * 2 + (h)) * HTB)
#define PG8_STAGE(bufoff, gbase, voff) do { _Pragma("unroll") for (int _i = 0; _i < 2; ++_i) \
        __builtin_amdgcn_global_load_lds((const unsigned*)((const char*)(gbase) + (voff)[_i]), (PG8_LAS unsigned*)(lds + (bufoff) + ldsw + _i * 8192), 16, 0, 0); } while (0)
#define PG8_LDA(dst, b, h) do { _Pragma("unroll") for (int m = 0; m < 4; ++m) _Pragma("unroll") for (int k = 0; k < 2; ++k) dst[m][k] = *(const PG8_LAS bf16x8*)(lds + PG8_SA(b, h) + aoff + m * 2048 + k * 1024); } while (0)
#define PG8_LDB(dst, b, h) do { _Pragma("unroll") for (int n = 0; n < 2; ++n) _Pragma("unroll") for (int k = 0; k < 2; ++k) dst[n][k] = *(const PG8_LAS bf16x8*)(lds + PG8_SB(b, h) + boff + n * 2048 + k * 1024); } while (0)
#define PG8_MMA(ai, bj, At, Bt) do { __builtin_amdgcn_s_setprio(1); _Pragma("unroll") for (int m = 0; m < 4; ++m) _Pragma("unroll") for (int n = 0; n < 2; ++n) _Pragma("unroll") for (int k = 0; k < 2; ++k) \
        acc[ai][bj][m][n] = __builtin_amdgcn_mfma_f32_16x16x32_bf16(Bt[n][k], At[m][k], acc[ai][bj][m][n], 0, 0, 0); __builtin_amdgcn_s_setprio(0); } while (0)
#define PG8_WAIT_V(n) asm volatile("s_waitcnt vmcnt(" #n ")" ::: "memory")
#define PG8_WAIT_L(n) asm volatile("s_waitcnt lgkmcnt(" #n ")" ::: "memory")
#define PG8_BAR __builtin_amdgcn_s_barrier()
#define PG8_SCHED __builtin_amdgcn_sched_barrier(0)
    Unit cur, nxt; int ui = 0;
    if (!S.next(0, cur)) return;
    f32x4 acc[2][2][4][2];
#pragma unroll
    for (int a = 0; a < 2; ++a)
#pragma unroll
        for (int b = 0; b < 2; ++b)
#pragma unroll
            for (int m = 0; m < 4; ++m)
#pragma unroll
                for (int n = 0; n < 2; ++n) acc[a][b][m][n] = (f32x4){0.f, 0.f, 0.f, 0.f};
    bf16x8 At[4][2], B0[2][2], B1[2][2];
    const char* cA = (const char*)g.A + (size_t)cur.pm * tstepA; const char* cB = (const char*)g.Bt + (size_t)cur.pn * tstepB;
    S.a_ready(cur);
    if constexpr (SP2) {
        PG8_STAGE(PG8_SB(0, 0), cB, voffB); PG8_STAGE(PG8_SB(0, 1), cB + hstepB, voffB); PG8_STAGE(PG8_SA(0, 0), cA, voffA); PG8_STAGE(PG8_SA(0, 1), cA + hstepA, voffA);
        if (wr == 1) PG8_BAR;
        PG8_WAIT_V(2); PG8_BAR;
        PG8_STAGE(PG8_SB(1, 0), cB + kstep, voffB); PG8_STAGE(PG8_SA(1, 0), cA + kstep, voffA); PG8_STAGE(PG8_SB(1, 1), cB + hstepB + kstep, voffB);
        PG8_WAIT_V(6); PG8_BAR;
    } else {
        PG8_STAGE(PG8_SB(0, 0), cB, voffB); PG8_STAGE(PG8_SA(0, 0), cA, voffA); PG8_STAGE(PG8_SB(0, 1), cB + hstepB, voffB); PG8_STAGE(PG8_SA(0, 1), cA + hstepA, voffA);
        if (wr == 1) PG8_BAR;
        PG8_WAIT_V(4); PG8_BAR;
        PG8_STAGE(PG8_SB(1, 0), cB + kstep, voffB); PG8_STAGE(PG8_SA(1, 0), cA + kstep, voffA); PG8_STAGE(PG8_SB(1, 1), cB + hstepB + kstep, voffB);
        PG8_WAIT_V(6); PG8_BAR;
    }
    for (;;) {
        const bool has_next = S.next(ui + 1, nxt);
        const char* nA = has_next ? (const char*)g.A + (size_t)nxt.pm * tstepA : cA; const char* nB = has_next ? (const char*)g.Bt + (size_t)nxt.pn * tstepB : cB;
        for (int t = 0; t < nt; t += 2) {
            const bool last = (t == nt - 2);
            const char* a1 = cA + (size_t)(t + 1) * kstep;
            const char* a2 = last ? nA : cA + (size_t)(t + 2) * kstep; const char* b2 = last ? nB : cB + (size_t)(t + 2) * kstep;
            const char* a3 = a2 + kstep; const char* b3 = b2 + kstep;
            if (last && has_next) S.a_ready(nxt);
            if constexpr (SP2) {
            PG8_LDB(B0, 0, 0); PG8_LDB(B1, 0, 1); PG8_SCHED; PG8_LDA(At, 0, 0); PG8_STAGE(PG8_SA(1, 1), a1 + hstepA, voffA);
            PG8_WAIT_V(8); PG8_WAIT_L(0); PG8_BAR; PG8_MMA(0, 0, At, B0); PG8_MMA(0, 1, At, B1); PG8_BAR; PG8_SCHED;
            PG8_LDA(At, 0, 1); PG8_STAGE(PG8_SB(0, 0), b2, voffB); PG8_STAGE(PG8_SB(0, 1), b2 + hstepB, voffB); PG8_STAGE(PG8_SA(0, 0), a2, voffA);
            PG8_WAIT_V(8); PG8_WAIT_L(0); PG8_BAR; PG8_MMA(1, 0, At, B0); PG8_MMA(1, 1, At, B1); PG8_BAR; PG8_SCHED;
            PG8_LDB(B0, 1, 0); PG8_LDB(B1, 1, 1); PG8_SCHED; PG8_LDA(At, 1, 0); PG8_STAGE(PG8_SA(0, 1), a2 + hstepA, voffA);
            PG8_WAIT_V(8); PG8_WAIT_L(0); PG8_BAR; PG8_MMA(0, 0, At, B0); PG8_MMA(0, 1, At, B1); PG8_BAR; PG8_SCHED;
            PG8_LDA(At, 1, 1); PG8_STAGE(PG8_SB(1, 0), b3, voffB); PG8_STAGE(PG8_SB(1, 1), b3 + hstepB, voffB); PG8_STAGE(PG8_SA(1, 0), a3, voffA);
            PG8_WAIT_V(8); PG8_WAIT_L(0); PG8_BAR; PG8_MMA(1, 0, At, B0); PG8_MMA(1, 1, At, B1); PG8_BAR; PG8_SCHED;
            } else {
            PG8_LDB(B0, 0, 0); PG8_SCHED; PG8_LDA(At, 0, 0); PG8_STAGE(PG8_SA(1, 1), a1 + hstepA, voffA);
            PG8_WAIT_L(8); PG8_BAR; PG8_WAIT_L(0); PG8_MMA(0, 0, At, B0); PG8_BAR; PG8_SCHED;
            PG8_LDB(B1, 0, 1); PG8_STAGE(PG8_SB(0, 0), b2, voffB);
            PG8_BAR; PG8_WAIT_L(0); PG8_MMA(0, 1, At, B1); PG8_BAR;
            PG8_LDA(At, 0, 1); PG8_STAGE(PG8_SA(0, 0), a2, voffA);
            PG8_BAR; PG8_WAIT_L(0); PG8_MMA(1, 0, At, B0); PG8_BAR; PG8_SCHED;
            PG8_STAGE(PG8_SB(0, 1), b2 + hstepB, voffB);
            PG8_WAIT_V(6); PG8_BAR; PG8_MMA(1, 1, At, B1); PG8_BAR;
            PG8_LDB(B0, 1, 0); PG8_SCHED; PG8_LDA(At, 1, 0); PG8_STAGE(PG8_SA(0, 1), a2 + hstepA, voffA);
            PG8_WAIT_L(8); PG8_BAR; PG8_WAIT_L(0); PG8_MMA(0, 0, At, B0); PG8_BAR; PG8_SCHED;
            PG8_LDB(B1, 1, 1); PG8_STAGE(PG8_SB(1, 0), b3, voffB);
            PG8_BAR; PG8_WAIT_L(0); PG8_MMA(0, 1, At, B1); PG8_BAR;
            PG8_LDA(At, 1, 1); PG8_STAGE(PG8_SA(1, 0), a3, voffA);
            PG8_BAR; PG8_WAIT_L(0); PG8_MMA(1, 0, At, B0); PG8_BAR; PG8_SCHED;
            PG8_STAGE(PG8_SB(1, 1), b3 + hstepB, voffB);
            PG8_WAIT_V(6); PG8_BAR; PG8_MMA(1, 1, At, B1); PG8_BAR;
            }
        }
        if constexpr (ALIGN_EPI) { if (wr == 0) PG8_BAR; }
        if constexpr (!Epi::AFTER_DRAIN) { E(acc, cur, wr, wc, fr, fq); S.done(cur); }
        if (!has_next) break;
#pragma unroll
        for (int a = 0; a < 2; ++a)
#pragma unroll
            for (int b = 0; b < 2; ++b)
#pragma unroll
                for (int m = 0; m < 4; ++m)
#pragma unroll
                    for (int n = 0; n < 2; ++n) acc[a][b][m][n] = (f32x4){0.f, 0.f, 0.f, 0.f};
        cur = nxt; cA = nA; cB = nB; ++ui;
        if constexpr (ALIGN_EPI) { if (wr == 1) PG8_BAR; }
    }
    PG8_WAIT_V(0);
    if constexpr (!ALIGN_EPI) { if (wr == 0) PG8_BAR; }
    PG8_BAR;
    if constexpr (Epi::AFTER_DRAIN) { E.fused(acc, cur, wr, wc, fr, fq, lds, wid, lane); S.done(cur); }
#undef PG8_SA
#undef PG8_SB
#undef PG8_STAGE
#undef PG8_LDA
#undef PG8_LDB
#undef PG8_MMA
#undef PG8_WAIT_V
#undef PG8_WAIT_L
#undef PG8_BAR
#undef PG8_SCHED
}
}

constexpr int SEQ = 16384, DM = 1024, INC = 3072, FF = 4096, MEML = 256;
constexpr float RMS_EPS = 1e-6f;
constexpr float LOG2E = 1.4426950408889634f;
constexpr float LAM_INIT = 0.2f;

#define LAS __attribute__((address_space(3)))
typedef unsigned short bf16;
typedef short bf16x8 __attribute__((ext_vector_type(8)));
typedef float f32x4 __attribute__((ext_vector_type(4)));
typedef float f32x16 __attribute__((ext_vector_type(16)));
typedef unsigned u32x4 __attribute__((ext_vector_type(4)));
typedef unsigned u32x2 __attribute__((ext_vector_type(2)));

constexpr size_t MiB = 1u << 20;
constexpr size_t WS_SSQ1 = 0, WS_SSQ2 = 65536, WS_SSQ3 = 131072, WS_ROPE = 262144;
constexpr size_t WS_MEMN = 1536 * 1024, WS_KV = 2 * MiB, WS_BAR = 3 * MiB, BAR_BYTES = 16384;
constexpr size_t WS_WIN = 4 * MiB, WS_WOUT = 10 * MiB, WS_WXQ = 12 * MiB, WS_WXKV = 14 * MiB, WS_WXO = 18 * MiB, WS_WUP = 20 * MiB, WS_WDN = 28 * MiB, WS_WQK = 36 * MiB, WS_WVO = 38 * MiB;
constexpr size_t WS_XN = 40 * MiB, WS_P = 40 * MiB;
constexpr size_t WS_QD = 72 * MiB, WS_KD = 88 * MiB, WS_QS = 104 * MiB, WS_KS = 120 * MiB, WS_VT = 136 * MiB;
constexpr size_t WS_ACT = 40 * MiB;
constexpr size_t WS_Y = 168 * MiB, WS_H2B = 168 * MiB, WS_H1B = 200 * MiB, WS_END = 232 * MiB;

constexpr int LDS_BYTES = 136 * 1024;

__device__ __forceinline__ unsigned cvtpk(float lo, float hi) { unsigned r; asm volatile("v_cvt_pk_bf16_f32 %0, %1, %2" : "=v"(r) : "v"(lo), "v"(hi)); return r; }
__device__ __forceinline__ unsigned short f2bf(float f) { return (unsigned short)(cvtpk(f, f) & 0xffffu); }
__device__ __forceinline__ float wave_sum(float v) {
#pragma unroll
    for (int o = 1; o < 64; o <<= 1) v += __shfl_xor(v, o);
    return v;
}
__device__ __forceinline__ int crow(int r, int hi) { return (r & 3) + 8 * (r >> 2) + 4 * hi; }

using pg8::Unit;

struct EpiInProj {
    static constexpr bool PERM = true, AFTER_DRAIN = false;
    bf16 *Qd, *Kd, *Qs, *Ks, *Vt; const float2* rope; const float* rstd0;
    __device__ __forceinline__ void operator()(const f32x4 (&acc)[2][2][4][2], const Unit& u, int wr, int wc, int fr, int fq) const {
        const int region = u.pn >> 1;
        const int row0 = u.pm * 256 + wr * 64 + fr;
        if (region == 2 || region == 5) {
            const int vrow0 = (region == 5 ? 512 : 0) + (u.pn & 1) * 256 + wc * 32 + 8 * fq;
#pragma unroll
            for (int ai = 0; ai < 2; ++ai)
#pragma unroll
                for (int m = 0; m < 4; ++m) {
                    const int row = row0 + ai * 128 + m * 16; const int x = row & 15;
                    const int pos = (row & ~15) | (x & 3) | ((x & 4) << 1) | ((x & 8) >> 1);
                    const float rs = rstd0[row];
#pragma unroll
                    for (int bj = 0; bj < 2; ++bj)
#pragma unroll
                        for (int n = 0; n < 2; ++n)
#pragma unroll
                            for (int e = 0; e < 4; ++e) Vt[(size_t)(vrow0 + bj * 128 + 4 * n + e) * SEQ + pos] = f2bf(acc[ai][bj][m][n][e] * rs);
                }
        } else {
            bf16* base = region == 0 ? Qd : region == 1 ? Kd : region == 3 ? Qs : Ks;
            const float sc = region == 0 ? 0.125f * LOG2E : region == 3 ? 0.125f : 1.f;
            const bool rope_on = (region < 2) && ((wc & 1) == 0);
            const int d0 = (wc & 1) * 32 + 8 * fq;
#pragma unroll
            for (int ai = 0; ai < 2; ++ai)
#pragma unroll
                for (int m = 0; m < 4; ++m) {
                    const int row = row0 + ai * 128 + m * 16;
                    const float scr_ = sc * rstd0[row];
#pragma unroll
                    for (int bj = 0; bj < 2; ++bj) {
                        const int head = (u.pn & 1) * 4 + 2 * bj + (wc >> 1);
                        f32x4 v0 = acc[ai][bj][m][0], v1 = acc[ai][bj][m][1];
                        if (rope_on) {
                            f32x4 p0, p1;
#pragma unroll
                            for (int e = 0; e < 4; ++e) { p0[e] = __shfl_xor(v0[e], 16); p1[e] = __shfl_xor(v1[e], 16); }
                            if (fq < 2) {
                                const float sg = fq == 0 ? -1.f : 1.f;
                                const float2* rp = rope + (size_t)row * 8;
#pragma unroll
                                for (int e = 0; e < 4; ++e) {
                                    const float2 c0 = rp[e], c1 = rp[4 + e];
                                    v0[e] = v0[e] * c0.x + sg * p0[e] * c0.y;
                                    v1[e] = v1[e] * c1.x + sg * p1[e] * c1.y;
                                }
                            }
                        }
                        u32x4 w; w.x = cvtpk(v0[0] * scr_, v0[1] * scr_); w.y = cvtpk(v0[2] * scr_, v0[3] * scr_); w.z = cvtpk(v1[0] * scr_, v1[1] * scr_); w.w = cvtpk(v1[2] * scr_, v1[3] * scr_);
                        *(u32x4*)(base + ((size_t)head * SEQ + row) * 64 + d0) = w;
                    }
                }
        }
    }
};

__device__ __forceinline__ f32x4 bf4_to_f32(u32x2 w) { f32x4 r; r[0] = __uint_as_float(w.x << 16); r[1] = __uint_as_float(w.x & 0xffff0000u); r[2] = __uint_as_float(w.y << 16); r[3] = __uint_as_float(w.y & 0xffff0000u); return r; }
template <bool BASE_BF16> struct EpiRes {
    static constexpr bool PERM = true, AFTER_DRAIN = false;
    const void* base; bf16* outb; float* ssq;
    __device__ __forceinline__ void operator()(const f32x4 (&acc)[2][2][4][2], const Unit& u, int wr, int wc, int fr, int fq) const {
        const int col0 = u.pn * 256 + wc * 32 + 8 * fq;
#pragma unroll
        for (int ai = 0; ai < 2; ++ai)
#pragma unroll
            for (int m = 0; m < 4; ++m) {
                const int row = u.pm * 256 + ai * 128 + wr * 64 + m * 16 + fr; const size_t off = (size_t)row * DM + col0; float s = 0.f;
#pragma unroll
                for (int bj = 0; bj < 2; ++bj) {
                    f32x4 b0, b1;
                    if (BASE_BF16) { const u32x4 w = __builtin_nontemporal_load((const u32x4*)((const bf16*)base + off + bj * 128)); u32x2 lo, hi; lo.x = w.x; lo.y = w.y; hi.x = w.z; hi.y = w.w; b0 = bf4_to_f32(lo); b1 = bf4_to_f32(hi); }
                    else { b0 = __builtin_nontemporal_load((const f32x4*)((const float*)base + off + bj * 128)); b1 = __builtin_nontemporal_load((const f32x4*)((const float*)base + off + bj * 128 + 4)); }
                    const f32x4 o0 = b0 + acc[ai][bj][m][0], o1 = b1 + acc[ai][bj][m][1];
                    s += ((o0[0] * o0[0] + o0[1] * o0[1]) + (o0[2] * o0[2] + o0[3] * o0[3])) + ((o1[0] * o1[0] + o1[1] * o1[1]) + (o1[2] * o1[2] + o1[3] * o1[3]));
                    u32x4 wo; wo.x = cvtpk(o0[0], o0[1]); wo.y = cvtpk(o0[2], o0[3]); wo.z = cvtpk(o1[0], o1[1]); wo.w = cvtpk(o1[2], o1[3]);
                    *(u32x4*)(outb + off + bj * 128) = wo;
                }
                s += __shfl_xor(s, 16); s += __shfl_xor(s, 32);
                if (fq == 0) atomicAdd(ssq + row, s);
            }
    }
};

struct EpiResF32 {
    static constexpr bool PERM = false, AFTER_DRAIN = false;
    const bf16* base; float* out; float* ssq;
    __device__ __forceinline__ void operator()(const f32x4 (&acc)[2][2][4][2], const Unit& u, int wr, int wc, int fr, int fq) const {
        const int col0 = u.pn * 256 + wc * 32 + 4 * fq;
#pragma unroll
        for (int ai = 0; ai < 2; ++ai)
#pragma unroll
            for (int m = 0; m < 4; ++m) {
                const int row = u.pm * 256 + ai * 128 + wr * 64 + m * 16 + fr; const size_t off = (size_t)row * DM + col0; float s = 0.f;
#pragma unroll
                for (int bj = 0; bj < 2; ++bj)
#pragma unroll
                    for (int n = 0; n < 2; ++n) {
                        const f32x4 o = bf4_to_f32(*(const u32x2*)(base + off + bj * 128 + n * 16)) + acc[ai][bj][m][n];
                        *(f32x4*)(out + off + bj * 128 + n * 16) = o; s += (o[0] * o[0] + o[1] * o[1]) + (o[2] * o[2] + o[3] * o[3]);
                    }
                s += __shfl_xor(s, 16); s += __shfl_xor(s, 32);
                if (fq == 0) atomicAdd(ssq + row, s);
            }
    }
};

struct EpiPlain {
    static constexpr bool PERM = true, AFTER_DRAIN = false;
    bf16* O; int ldc, row_off, col_off; const float* colscale; float scale;
    __device__ __forceinline__ void operator()(const f32x4 (&acc)[2][2][4][2], const Unit& u, int wr, int wc, int fr, int fq) const {
#pragma unroll
        for (int bj = 0; bj < 2; ++bj) {
            const int col = u.pn * 256 + bj * 128 + wc * 32 + 8 * fq;
            f32x4 c0 = (f32x4){scale, scale, scale, scale}, c1 = c0;
            if (colscale) { c0 = *(const f32x4*)(colscale + col) * scale; c1 = *(const f32x4*)(colscale + col + 4) * scale; }
#pragma unroll
            for (int ai = 0; ai < 2; ++ai)
#pragma unroll
                for (int m = 0; m < 4; ++m) {
                    const int row = row_off + u.pm * 256 + ai * 128 + wr * 64 + m * 16 + fr;
                    const f32x4 v0 = acc[ai][bj][m][0] * c0, v1 = acc[ai][bj][m][1] * c1;
                    u32x4 w; w.x = cvtpk(v0[0], v0[1]); w.y = cvtpk(v0[2], v0[3]); w.z = cvtpk(v1[0], v1[1]); w.w = cvtpk(v1[2], v1[3]);
                    *(u32x4*)(O + (size_t)row * ldc + col_off + col) = w;
                }
        }
    }
};

struct EpiUp {
    static constexpr bool PERM = true, AFTER_DRAIN = false;
    const float* ssq; bf16* O;
    __device__ __forceinline__ void operator()(const f32x4 (&acc)[2][2][4][2], const Unit& u, int wr, int wc, int fr, int fq) const {
#pragma unroll
        for (int ai = 0; ai < 2; ++ai)
#pragma unroll
            for (int m = 0; m < 4; ++m) {
                const int row = u.pm * 256 + ai * 128 + wr * 64 + m * 16 + fr;
                const float rstd = 1.0f / sqrtf(ssq[row] * (1.0f / DM) + RMS_EPS);
#pragma unroll
                for (int bj = 0; bj < 2; ++bj) {
                    f32x4 v0 = acc[ai][bj][m][0] * rstd, v1 = acc[ai][bj][m][1] * rstd;
#pragma unroll
                    for (int e = 0; e < 4; ++e) { const float a = fmaxf(v0[e], 0.f), b = fmaxf(v1[e], 0.f); v0[e] = a * a; v1[e] = b * b; }
                    u32x4 w; w.x = cvtpk(v0[0], v0[1]); w.y = cvtpk(v0[2], v0[3]); w.z = cvtpk(v1[0], v1[1]); w.w = cvtpk(v1[2], v1[3]);
                    *(u32x4*)(O + (size_t)row * FF + u.pn * 256 + bj * 128 + wc * 32 + 8 * fq) = w;
                }
            }
    }
};

struct EpiCrossSoftmax {
    static constexpr bool PERM = true, AFTER_DRAIN = true;
    const float* ssq; bf16* P;
    __device__ __forceinline__ void fused(f32x4 (&acc)[2][2][4][2], const Unit& u, int wr, int wc, int fr, int fq, LAS unsigned char* lds, int wid, int lane) const {
        LAS float* Pm = (LAS float*)lds; LAS float* Ps = (LAS float*)(lds + 4096);
#pragma unroll
        for (int ai = 0; ai < 2; ++ai)
#pragma unroll
            for (int m = 0; m < 4; ++m) {
                const int r = ai * 128 + wr * 64 + m * 16 + fr;
                const float rstd = LOG2E / sqrtf(ssq[u.pm * 256 + r] * (1.0f / DM) + RMS_EPS);
                float mx = -3.0e38f;
#pragma unroll
                for (int bj = 0; bj < 2; ++bj)
#pragma unroll
                    for (int n = 0; n < 2; ++n)
#pragma unroll
                        for (int e = 0; e < 4; ++e) { const float v = acc[ai][bj][m][n][e] * rstd; acc[ai][bj][m][n][e] = v; mx = fmaxf(mx, v); }
                mx = fmaxf(mx, __shfl_xor(mx, 16)); mx = fmaxf(mx, __shfl_xor(mx, 32));
                if (fq == 0) Pm[r * 4 + wc] = mx;
            }
        __syncthreads();
#pragma unroll
        for (int ai = 0; ai < 2; ++ai)
#pragma unroll
            for (int m = 0; m < 4; ++m) {
                const int r = ai * 128 + wr * 64 + m * 16 + fr;
                const f32x4 pm = *(const LAS f32x4*)(Pm + r * 4);
                const float M = fmaxf(fmaxf(pm[0], pm[1]), fmaxf(pm[2], pm[3]));
                float s = 0.f;
#pragma unroll
                for (int bj = 0; bj < 2; ++bj)
#pragma unroll
                    for (int n = 0; n < 2; ++n)
#pragma unroll
                        for (int e = 0; e < 4; ++e) { const float p = __builtin_amdgcn_exp2f(acc[ai][bj][m][n][e] - M); acc[ai][bj][m][n][e] = p; s += p; }
                s += __shfl_xor(s, 16); s += __shfl_xor(s, 32);
                if (fq == 0) Ps[r * 4 + wc] = s;
            }
        __syncthreads();
#pragma unroll
        for (int ai = 0; ai < 2; ++ai)
#pragma unroll
            for (int m = 0; m < 4; ++m) {
                const int r = ai * 128 + wr * 64 + m * 16 + fr;
                const f32x4 ps = *(const LAS f32x4*)(Ps + r * 4);
                const float inv = 1.0f / ((ps[0] + ps[1]) + (ps[2] + ps[3]));
#pragma unroll
                for (int bj = 0; bj < 2; ++bj) {
                    const f32x4 v0 = acc[ai][bj][m][0] * inv, v1 = acc[ai][bj][m][1] * inv;
                    u32x4 w; w.x = cvtpk(v0[0], v0[1]); w.y = cvtpk(v0[2], v0[3]); w.z = cvtpk(v1[0], v1[1]); w.w = cvtpk(v1[2], v1[3]);
                    *(u32x4*)(P + (size_t)(u.pm * 256 + r) * DM + u.pn * 256 + bj * 128 + wc * 32 + 8 * fq) = w;
                }
            }
        __syncthreads();
    }
};

struct EpiResFinal {
    static constexpr bool PERM = true, AFTER_DRAIN = true;
    const bf16* base; float* out; float* ssq; unsigned* cnt; const float* gfin;
    __device__ __forceinline__ void fused(f32x4 (&acc)[2][2][4][2], const Unit& u, int wr, int wc, int fr, int fq, LAS unsigned char* lds, int wid, int lane) const {
        const int col0 = u.pn * 256 + wc * 32 + 8 * fq;
#pragma unroll
        for (int ai = 0; ai < 2; ++ai)
#pragma unroll
            for (int m = 0; m < 4; ++m) {
                const int row = u.pm * 256 + ai * 128 + wr * 64 + m * 16 + fr; const size_t off = (size_t)row * DM + col0; float s = 0.f;
#pragma unroll
                for (int bj = 0; bj < 2; ++bj) {
                    const u32x4 w = *(const u32x4*)(base + off + bj * 128); u32x2 lo, hi; lo.x = w.x; lo.y = w.y; hi.x = w.z; hi.y = w.w;
                    const f32x4 o0 = bf4_to_f32(lo) + acc[ai][bj][m][0], o1 = bf4_to_f32(hi) + acc[ai][bj][m][1];
                    acc[ai][bj][m][0] = o0; acc[ai][bj][m][1] = o1;
                    s += ((o0[0] * o0[0] + o0[1] * o0[1]) + (o0[2] * o0[2] + o0[3] * o0[3])) + ((o1[0] * o1[0] + o1[1] * o1[1]) + (o1[2] * o1[2] + o1[3] * o1[3]));
                }
                s += __shfl_xor(s, 16); s += __shfl_xor(s, 32);
                if (fq == 0) atomicAdd(ssq + row, s);
            }
        asm volatile("s_waitcnt vmcnt(0)" ::: "memory");
        __syncthreads();
        if (threadIdx.x == 0) {
            __builtin_amdgcn_fence(__ATOMIC_RELEASE, "agent");
            asm volatile("s_waitcnt vmcnt(0)" ::: "memory");
            __hip_atomic_fetch_add(cnt + u.pm, 1u, __ATOMIC_RELAXED, __HIP_MEMORY_SCOPE_AGENT);
            unsigned sp = 0;
            while (__hip_atomic_load(cnt + u.pm, __ATOMIC_RELAXED, __HIP_MEMORY_SCOPE_AGENT) < 4u) { __builtin_amdgcn_s_sleep(1); if (++sp > (1u << 22)) break; }
            __builtin_amdgcn_fence(__ATOMIC_ACQUIRE, "agent");
        }
        __syncthreads();
#pragma unroll
        for (int ai = 0; ai < 2; ++ai)
#pragma unroll
            for (int m = 0; m < 4; ++m) {
                const int row = u.pm * 256 + ai * 128 + wr * 64 + m * 16 + fr; const size_t off = (size_t)row * DM + col0;
                const float rstd = 1.0f / sqrtf(__hip_atomic_load(ssq + row, __ATOMIC_RELAXED, __HIP_MEMORY_SCOPE_AGENT) * (1.0f / DM) + RMS_EPS);
#pragma unroll
                for (int bj = 0; bj < 2; ++bj)
#pragma unroll
                    for (int n = 0; n < 2; ++n) {
                        const f32x4 g = *(const f32x4*)(gfin + col0 + bj * 128 + 4 * n);
                        *(f32x4*)(out + off + bj * 128 + 4 * n) = acc[ai][bj][m][n] * rstd * g;
                    }
            }
    }
};

struct SmallOrder {
    int c0, nN, n, c;
    __device__ __forceinline__ bool next(int i, Unit& u) const { if (i) return false; const int L = c - c0; if (L < 0 || L >= n) return false; u.pm = L / nN; u.pn = L % nN; return true; }
    __device__ __forceinline__ void a_ready(const Unit&) const {}
    __device__ __forceinline__ void done(const Unit&) const {}
};

__device__ __forceinline__ void p0_transpose_item(const float* W, int K, int N, bf16* WT, const float* gain, LAS float* scr, int item, int lane) {
    const int nblk = N / 32, kb = item / nblk, nb = item % nblk, k0 = 64 * kb, n0 = 32 * nb;
#pragma unroll
    for (int i = 0; i < 8; ++i) {
        const int kk = 8 * i + (lane >> 3), nn = 4 * (lane & 7);
        f32x4 v = __builtin_nontemporal_load((const f32x4*)(W + (size_t)(k0 + kk) * N + n0 + nn)); if (gain) v = v * gain[k0 + kk];
        LAS float* d = scr + kk * 33 + nn; d[0] = v[0]; d[1] = v[1]; d[2] = v[2]; d[3] = v[3];
    }
    asm volatile("s_waitcnt lgkmcnt(0)" ::: "memory");
    const int c = lane & 7;
#pragma unroll
    for (int j = 0; j < 4; ++j) { const int n = (lane >> 3) + 8 * j; const LAS float* s = scr + (8 * c) * 33 + n;
        u32x4 o; o.x = cvtpk(s[0 * 33], s[1 * 33]); o.y = cvtpk(s[2 * 33], s[3 * 33]); o.z = cvtpk(s[4 * 33], s[5 * 33]); o.w = cvtpk(s[6 * 33], s[7 * 33]);
        *(u32x4*)(WT + (size_t)(n0 + n) * K + k0 + 8 * c) = o; }
    asm volatile("s_waitcnt lgkmcnt(0)" ::: "memory");
}
__device__ __forceinline__ void rms_row_to_bf16(const float* xrow, const float* g, bf16* orow, int lane) {
    const f32x4* xr = (const f32x4*)xrow + lane; const f32x4* gr = (const f32x4*)g + lane;
    f32x4 v[4]; float s = 0.f;
#pragma unroll
    for (int j = 0; j < 4; ++j) { v[j] = __builtin_nontemporal_load(xr + 64 * j); s += (v[j][0] * v[j][0] + v[j][1] * v[j][1]) + (v[j][2] * v[j][2] + v[j][3] * v[j][3]); }
    const float rstd = 1.0f / sqrtf(wave_sum(s) * (1.0f / DM) + RMS_EPS);
    u32x2* o8 = (u32x2*)orow + lane;
#pragma unroll
    for (int j = 0; j < 4; ++j) { const f32x4 gg = gr[64 * j]; u32x2 w; w.x = cvtpk(v[j][0] * rstd * gg[0], v[j][1] * rstd * gg[1]); w.y = cvtpk(v[j][2] * rstd * gg[2], v[j][3] * rstd * gg[3]); o8[64 * j] = w; }
}

__device__ __forceinline__ void row_to_bf16_rstd(const float* xrow, bf16* orow, float* rstd_out, int lane) {
    const f32x4* xr = (const f32x4*)xrow + lane;
    f32x4 v[4]; float s = 0.f;
#pragma unroll
    for (int j = 0; j < 4; ++j) { v[j] = __builtin_nontemporal_load(xr + 64 * j); s += (v[j][0] * v[j][0] + v[j][1] * v[j][1]) + (v[j][2] * v[j][2] + v[j][3] * v[j][3]); }
    s = wave_sum(s);
    if (lane == 0) *rstd_out = 1.0f / sqrtf(s * (1.0f / DM) + RMS_EPS);
    u32x2* o8 = (u32x2*)orow + lane;
#pragma unroll
    for (int j = 0; j < 4; ++j) { u32x2 w; w.x = cvtpk(v[j][0], v[j][1]); w.y = cvtpk(v[j][2], v[j][3]); o8[64 * j] = w; }
}

__device__ __forceinline__ void sb_wave_unit(int head, int qsub, const bf16* Qs, const bf16* Ks, const bf16* Vt, bf16* Y, int lane) {
    const int r32 = lane & 31, hi = lane >> 5;
    const int t0 = qsub * 32;
    const bf16* qp = Qs + ((size_t)head * SEQ + t0 + r32) * 64 + 8 * hi;
    bf16x8 qf[4];
#pragma unroll
    for (int s = 0; s < 4; ++s) qf[s] = *(const bf16x8*)(qp + 16 * s);
    f32x16 o0 = {}, o1 = {};
    float C = 0.f;
    const bf16* kbase = Ks + (size_t)head * SEQ * 64 + (size_t)r32 * 64 + 8 * hi;
    const bf16* vbase = Vt + (size_t)(512 + head * 64 + r32) * SEQ + 8 * hi;
    for (int kv0 = t0; kv0 >= 0; kv0 -= 32) {
        bf16x8 kf[4], vf0[2], vf1[2];
#pragma unroll
        for (int s = 0; s < 4; ++s) kf[s] = *(const bf16x8*)(kbase + (size_t)kv0 * 64 + 16 * s);
#pragma unroll
        for (int s = 0; s < 2; ++s) { vf0[s] = *(const bf16x8*)(vbase + kv0 + 16 * s); vf1[s] = *(const bf16x8*)(vbase + (size_t)32 * SEQ + kv0 + 16 * s); }
        f32x16 z = {};
#pragma unroll
        for (int s = 0; s < 4; ++s) z = __builtin_amdgcn_mfma_f32_32x32x16_bf16(kf[s], qf[s], z, 0, 0, 0);
        const bool diag = (kv0 == t0);
        float lm[16], sn[16];
#pragma unroll
        for (int r = 0; r < 16; ++r) {
            const float zz = z[r];
            const float e = __expf(-fabsf(zz));
            const float lp = __logf(1.0f + e);
            const bool valid = (!diag) || (crow(r, hi) < r32);
            lm[r] = valid ? -(fmaxf(zz, 0.f) + lp) : 0.f;
            sn[r] = valid ? (fmaxf(-zz, 0.f) + lp) : 1.0e30f;
        }
        float gs[4], ot[4], T[4];
#pragma unroll
        for (int G = 0; G < 4; ++G) { gs[G] = (lm[4 * G] + lm[4 * G + 1]) + (lm[4 * G + 2] + lm[4 * G + 3]); ot[G] = __shfl_xor(gs[G], 32); T[G] = gs[G] + ot[G]; }
        float sfx[4]; sfx[3] = 0.f; sfx[2] = T[3]; sfx[1] = T[3] + T[2]; sfx[0] = T[3] + T[2] + T[1];
        float a[16];
#pragma unroll
        for (int G = 0; G < 4; ++G) {
            const float off = C + sfx[G] + (hi == 0 ? ot[G] : 0.f);
            const float w2 = lm[4 * G + 3], w1 = w2 + lm[4 * G + 2], w0 = w1 + lm[4 * G + 1];
            a[4 * G + 3] = __expf(off - sn[4 * G + 3]);
            a[4 * G + 2] = __expf(off + w2 - sn[4 * G + 2]);
            a[4 * G + 1] = __expf(off + w1 - sn[4 * G + 1]);
            a[4 * G + 0] = __expf(off + w0 - sn[4 * G + 0]);
        }
        C += (T[0] + T[1]) + (T[2] + T[3]);
        u32x4 p0, p1;
        p0.x = cvtpk(a[0], a[1]); p0.y = cvtpk(a[2], a[3]); p0.z = cvtpk(a[4], a[5]); p0.w = cvtpk(a[6], a[7]);
        p1.x = cvtpk(a[8], a[9]); p1.y = cvtpk(a[10], a[11]); p1.z = cvtpk(a[12], a[13]); p1.w = cvtpk(a[14], a[15]);
        const bf16x8 pf0 = __builtin_bit_cast(bf16x8, p0), pf1 = __builtin_bit_cast(bf16x8, p1);
        o0 = __builtin_amdgcn_mfma_f32_32x32x16_bf16(vf0[0], pf0, o0, 0, 0, 0);
        o0 = __builtin_amdgcn_mfma_f32_32x32x16_bf16(vf0[1], pf1, o0, 0, 0, 0);
        o1 = __builtin_amdgcn_mfma_f32_32x32x16_bf16(vf1[0], pf0, o1, 0, 0, 0);
        o1 = __builtin_amdgcn_mfma_f32_32x32x16_bf16(vf1[1], pf1, o1, 0, 0, 0);
        if (__all(C < -100.0f)) break;
    }
    bf16* yp = Y + (size_t)(t0 + r32) * DM + 512 + head * 64 + 4 * hi;
#pragma unroll
    for (int g = 0; g < 4; ++g) {
        u32x2 w0, w1;
        w0.x = cvtpk(o0[4 * g], o0[4 * g + 1]); w0.y = cvtpk(o0[4 * g + 2], o0[4 * g + 3]);
        w1.x = cvtpk(o1[4 * g], o1[4 * g + 1]); w1.y = cvtpk(o1[4 * g + 2], o1[4 * g + 3]);
        *(u32x2*)(yp + 8 * g) = w0; *(u32x2*)(yp + 32 + 8 * g) = w1;
    }
}

constexpr int DA_PITCH = 128, DA_KB = 64 * DA_PITCH, DA_KBUF = 2 * DA_KB, DA_VB = 128 * DA_PITCH, DA_NSLOT = 3, DA_VOFF = DA_NSLOT * DA_KBUF, DA_QOFF = DA_VOFF + DA_NSLOT * DA_VB;
__device__ __forceinline__ float max3f(float a, float b, float c) { float r; asm volatile("v_max3_f32 %0, %1, %2, %3" : "=v"(r) : "v"(a), "v"(b), "v"(c)); return r; }
__device__ __forceinline__ float da_rowmax(f32x16& a, f32x16& b) {
    asm volatile("s_nop 15\n\ts_nop 7" : "+v"(a), "+v"(b));
    float m0 = max3f(a[0], a[1], a[2]), m1 = max3f(b[0], b[1], b[2]);
#pragma unroll
    for (int r = 3; r < 15; r += 2) { m0 = max3f(m0, a[r], a[r + 1]); m1 = max3f(m1, b[r], b[r + 1]); }
    float m = max3f(m0, m1, a[15]); m = max3f(m, b[15], b[15]);
    const auto rr = __builtin_amdgcn_permlane32_swap(__float_as_uint(m), __float_as_uint(m), false, false);
    return fmaxf(__uint_as_float(rr[0]), __uint_as_float(rr[1]));
}
__device__ __forceinline__ void da_mask(f32x16& s0, f32x16& s1, int kv0, int qrow, int hi) {
#pragma unroll
    for (int r = 0; r < 16; ++r) { const int kv = kv0 + crow(r, hi); if (kv > qrow) s0[r] = -1.0e30f; if (kv + 32 > qrow) s1[r] = -1.0e30f; }
}
template <bool DO_QK, bool DO_PV>
__device__ __forceinline__ void da_core(f32x16 (&o)[4], f32x16& s0, f32x16& s1, f32x16& n0, f32x16& n1, const f32x16& negm, const u32x4 (&pp)[4], float& l,
                                        const LAS unsigned char* qb, LAS unsigned char* kt, LAS unsigned char* vt, const int (&xo)[4]) {
    if (DO_QK) {
#pragma unroll
        for (int s = 0; s < 4; ++s) {
            const bf16x8 ka = *(const LAS bf16x8*)(kt + xo[s]), kb = *(const LAS bf16x8*)(kt + 32 * DA_PITCH + xo[s]);
            const bf16x8 qv = *(const LAS bf16x8*)(qb + s * 1024);
            n0 = __builtin_amdgcn_mfma_f32_32x32x16_bf16(ka, qv, s == 0 ? negm : n0, 0, 0, 0); n1 = __builtin_amdgcn_mfma_f32_32x32x16_bf16(kb, qv, s == 0 ? negm : n1, 0, 0, 0);
        }
    }
    if (DO_PV) {
#pragma unroll
        for (int db = 0; db < 4; ++db)
#pragma unroll
            for (int s = 0; s < 4; ++s) {
                const bf16x8 va = *(const LAS bf16x8*)(vt + db * 32 * DA_PITCH + xo[s]);
                o[db] = __builtin_amdgcn_mfma_f32_32x32x16_bf16(va, __builtin_bit_cast(bf16x8, pp[s]), o[db], 0, 0, 0);
            }
    }
    float ps = 0.f;
#pragma unroll
    for (int r = 0; r < 16; ++r) { s0[r] = __builtin_amdgcn_exp2f(s0[r]); s1[r] = __builtin_amdgcn_exp2f(s1[r]); ps += s0[r] + s1[r]; }
    l += ps;
}
struct DaDma { const bf16 *k0, *k1, *v0, *v1; size_t ko, vo; LAS unsigned char *kd, *vd; };
template <bool DMA_IN>
__device__ __forceinline__ void da_core_mid(f32x16 (&o)[4], f32x16& s0, f32x16& s1, f32x16& n0, f32x16& n1, const f32x16& negm, const u32x4 (&pp)[4], float& l,
                                            const LAS unsigned char* qb, LAS unsigned char* kt, LAS unsigned char* vt, const int (&xo)[4], float& mpart, const DaDma& dm) {
    bf16x8 fa[24], fq[4];
    float ps = 0.f, m0 = 0.f, m1 = 0.f;
#define DA_RD(j) do { if ((j) < 8) { fa[(j)] = *(const LAS bf16x8*)(kt + ((j) & 1) * 32 * DA_PITCH + xo[((j) >> 1) & 3]); if (((j) & 1) == 0) fq[((j) >> 1) & 3] = *(const LAS bf16x8*)(qb + (((j) >> 1) & 3) * 1024); } \
                      else { fa[(j)] = *(const LAS bf16x8*)(vt + (((j) - 8) & 3) * 32 * DA_PITCH + xo[(((j) - 8) >> 2) & 3]); } } while (0)
#define DA_EX(k) do { float a_; if ((k) & 1) { a_ = __builtin_amdgcn_exp2f(s1[(k) >> 1]); asm volatile("" : "+v"(a_)); s1[(k) >> 1] = a_; } else { a_ = __builtin_amdgcn_exp2f(s0[(k) >> 1]); asm volatile("" : "+v"(a_)); s0[(k) >> 1] = a_; } } while (0)
#define DA_AD(k) do { ps += ((k) & 1) ? s1[(k) >> 1] : s0[(k) >> 1]; } while (0)
    DA_RD(0); DA_RD(1); DA_RD(2); DA_RD(3);
    __builtin_amdgcn_s_setprio(1);
    __builtin_amdgcn_sched_barrier(0);
#pragma unroll
    for (int j = 0; j < 24; ++j) {
        if ((j & 3) == 0 && j + 4 < 24) { DA_RD(j + 4); DA_RD(j + 5); DA_RD(j + 6); DA_RD(j + 7); __builtin_amdgcn_sched_barrier(0); }
        if (j < 8) {
            const int sq = j >> 1;
            if ((j & 1) == 0) n0 = __builtin_amdgcn_mfma_f32_32x32x16_bf16(fa[j], fq[sq], sq == 0 ? negm : n0, 0, 0, 0);
            else              n1 = __builtin_amdgcn_mfma_f32_32x32x16_bf16(fa[j], fq[sq], sq == 0 ? negm : n1, 0, 0, 0);
        } else {
            const int sv = (j - 8) >> 2, db = (j - 8) & 3;
            o[db] = __builtin_amdgcn_mfma_f32_32x32x16_bf16(fa[j], __builtin_bit_cast(bf16x8, pp[sv]), o[db], 0, 0, 0);
        }
        const int k0 = (4 * j) / 3, k1 = (4 * (j + 1)) / 3;
#pragma unroll
        for (int k = 0; k < 32; ++k) if (k >= k0 && k < k1) DA_EX(k);
        if (j > 0) { const int a0 = (4 * (j - 1)) / 3, a1 = (4 * j) / 3;
#pragma unroll
            for (int k = 0; k < 32; ++k) if (k >= a0 && k < a1) DA_AD(k);
            asm volatile("" : "+v"(ps)); }
        if (DMA_IN) {
            if (j >= 1 && j <= 4) {
                const bf16* p = (j == 1) ? dm.k0 + dm.ko : (j == 2) ? dm.k1 + dm.ko : (j == 3) ? dm.v0 + dm.vo : dm.v1 + dm.vo;
                asm volatile("" : "+v"(p));
                LAS unsigned char* d = (j == 1) ? dm.kd : (j == 2) ? dm.kd + DA_KB : (j == 3) ? dm.vd : dm.vd + 8192;
                __builtin_amdgcn_global_load_lds((const unsigned*)p, (LAS unsigned*)d, 16, 0, 0);
            }
        }
        if (j == 12) { m0 = max3f(n0[0], n0[1], n0[2]); m1 = max3f(n1[0], n1[1], n1[2]); }
        if (j >= 13 && j <= 18) { const int r = 3 + 2 * (j - 13); m0 = max3f(m0, n0[r], n0[r + 1]); m1 = max3f(m1, n1[r], n1[r + 1]); }
        if (j == 19) { m0 = max3f(m0, m1, n0[15]); m0 = max3f(m0, n1[15], n1[15]); }
        __builtin_amdgcn_sched_barrier(0);
    }
    __builtin_amdgcn_s_setprio(0);
    mpart = m0;
    DA_AD(30); DA_AD(31);
#undef DA_RD
#undef DA_EX
#undef DA_AD
    l += ps;
}
__device__ __forceinline__ void da_pack(u32x4 (&pp)[4], const f32x16& s0, const f32x16& s1) {
    pp[0].x = cvtpk(s0[0], s0[1]); pp[0].y = cvtpk(s0[2], s0[3]); pp[0].z = cvtpk(s0[4], s0[5]); pp[0].w = cvtpk(s0[6], s0[7]);
    pp[1].x = cvtpk(s0[8], s0[9]); pp[1].y = cvtpk(s0[10], s0[11]); pp[1].z = cvtpk(s0[12], s0[13]); pp[1].w = cvtpk(s0[14], s0[15]);
    pp[2].x = cvtpk(s1[0], s1[1]); pp[2].y = cvtpk(s1[2], s1[3]); pp[2].z = cvtpk(s1[4], s1[5]); pp[2].w = cvtpk(s1[6], s1[7]);
    pp[3].x = cvtpk(s1[8], s1[9]); pp[3].y = cvtpk(s1[10], s1[11]); pp[3].z = cvtpk(s1[12], s1[13]); pp[3].w = cvtpk(s1[14], s1[15]);
}
__device__ __forceinline__ void da_tail(f32x16 (&o)[4], f32x16& s0, f32x16& s1, f32x16& n0, f32x16& n1, f32x16& negm, float& l, bool boundary, int kv0n, int qrow, int hi, bool have_part = false, float mpart = 0.f) {
    float mt;
    if (boundary || !have_part) { if (boundary) da_mask(n0, n1, kv0n, qrow, hi); mt = da_rowmax(n0, n1); }
    else { const auto rr = __builtin_amdgcn_permlane32_swap(__float_as_uint(mpart), __float_as_uint(mpart), false, false); mt = fmaxf(__uint_as_float(rr[0]), __uint_as_float(rr[1])); }
    if (__any(mt > 8.0f)) {
        const float d = fmaxf(mt, 0.f), alpha = __builtin_amdgcn_exp2f(-d);
#pragma unroll
        for (int r = 0; r < 16; ++r) { n0[r] -= d; n1[r] -= d; negm[r] -= d; s0[r] *= alpha; s1[r] *= alpha; }
#pragma unroll
        for (int db = 0; db < 4; ++db) o[db] *= alpha;
        l *= alpha;
        asm volatile("" : "+v"(negm));
    }
}
__device__ __forceinline__ void diff_unit(int h, int qb, const bf16* Qd, const bf16* Kd, const bf16* Vt, bf16* Y, const float* g_subln, float lam, LAS unsigned char* lds) {
    int tid = threadIdx.x; asm volatile("" : "+v"(tid));
    const int lane = tid & 63, wave = __builtin_amdgcn_readfirstlane(tid >> 6), r32 = lane & 31, hi = lane >> 5;
    const int comp = wave >> 2, wq = wave & 3;
    const int q0 = qb * 128, qrow = q0 + wq * 32 + r32;
    const bf16* qp = Qd + ((size_t)(2 * h + comp) * SEQ + qrow) * 64 + 8 * hi;
    LAS unsigned char* qfb = lds + DA_QOFF + wave * 4096 + lane * 16;
#pragma unroll
    for (int s = 0; s < 4; ++s) *(LAS bf16x8*)(qfb + s * 1024) = *(const bf16x8*)(qp + 16 * s);
    const int NT = (q0 + 128) / 64;
    const int prow = lane >> 3, pch = (lane & 7) ^ ((4 * wave + (lane >> 4)) & 7);
    const bf16* gk0 = Kd + ((size_t)(2 * h) * SEQ + 8 * wave + prow) * 64 + pch * 8;
    const bf16* gk1 = Kd + ((size_t)(2 * h + 1) * SEQ + 8 * wave + prow) * 64 + pch * 8;
    const bf16* gv0 = Vt + (size_t)(h * 128 + 8 * wave + prow) * SEQ + pch * 8;
    const bf16* gv1 = Vt + (size_t)(h * 128 + 64 + 8 * wave + prow) * SEQ + pch * 8;
    LAS unsigned char* ldw = lds + wave * 1024;
#define DA_DMA(gp, dst) __builtin_amdgcn_global_load_lds((const unsigned*)(gp), (LAS unsigned*)(dst), 16, 0, 0)
#define DA_WAITBAR() do { asm volatile("s_waitcnt vmcnt(0) lgkmcnt(0)" ::: "memory"); __builtin_amdgcn_s_barrier(); asm volatile("" ::: "memory"); } while (0)
    int xo[4];
#pragma unroll
    for (int s = 0; s < 4; ++s) xo[s] = ((2 * s + hi) ^ ((r32 >> 1) & 7)) * 16;
    LAS unsigned char* kfrag = lds + comp * DA_KB + r32 * DA_PITCH;
    LAS unsigned char* vfrag = lds + DA_VOFF + r32 * DA_PITCH;
#define DA_WAITBAR_N(N) do { asm volatile("s_waitcnt vmcnt(" #N ") lgkmcnt(0)" ::: "memory"); __builtin_amdgcn_s_barrier(); asm volatile("" ::: "memory"); } while (0)
    DA_DMA(gk0, ldw); DA_DMA(gk1, ldw + DA_KB); DA_DMA(gk0 + 64 * 64, ldw + DA_KBUF); DA_DMA(gk1 + 64 * 64, ldw + DA_KBUF + DA_KB);
    if (2 < NT) { DA_DMA(gk0 + (size_t)2 * 64 * 64, ldw + 2 * DA_KBUF); DA_DMA(gk1 + (size_t)2 * 64 * 64, ldw + 2 * DA_KBUF + DA_KB); }
    DA_DMA(gv0, ldw + DA_VOFF); DA_DMA(gv1, ldw + DA_VOFF + 8192);
    if (2 < NT) DA_WAITBAR_N(4); else DA_WAITBAR_N(2);
    f32x16 o[4]; o[0] = f32x16{}; o[1] = f32x16{}; o[2] = f32x16{}; o[3] = f32x16{};
    f32x16 s0, s1, n0 = {}, n1 = {}, negm = {};
    u32x4 pp[4] = {};
    float l = 0.f;
    {
        da_core<true, false>(o, n0, n1, s0, s1, negm, pp, l, qfb, kfrag, vfrag, xo);
        if (NT == 2) da_mask(s0, s1, 0, qrow, hi);
        const float m0 = da_rowmax(s0, s1);
#pragma unroll
        for (int r = 0; r < 16; ++r) { s0[r] -= m0; s1[r] -= m0; negm[r] = -m0; }
        asm volatile("" : "+v"(negm));
        l = 0.f;
    }
    int ks1 = DA_KBUF, ks3 = 0, vsm = 2 * DA_VB, vs1 = DA_VB;
#define DA_ROT() do { ks3 = ks1; ks1 = (ks1 == 2 * DA_KBUF) ? 0 : ks1 + DA_KBUF; vsm = (vsm == 2 * DA_VB) ? 0 : vsm + DA_VB; vs1 = (vs1 == 2 * DA_VB) ? 0 : vs1 + DA_VB; } while (0)
    {
        int nd = 0;
        asm volatile("s_waitcnt lgkmcnt(0)" ::: "memory"); __builtin_amdgcn_s_barrier(); asm volatile("" ::: "memory");
        if (3 < NT) { DA_DMA(gk0 + (size_t)3 * 64 * 64, ldw + ks3); DA_DMA(gk1 + (size_t)3 * 64 * 64, ldw + ks3 + DA_KB); nd += 2; }
        DA_DMA(gv0 + 64, ldw + DA_VOFF + vs1); DA_DMA(gv1 + 64, ldw + DA_VOFF + vs1 + 8192); nd += 2;
        da_core<true, false>(o, s0, s1, n0, n1, negm, pp, l, qfb, kfrag + ks1, vfrag, xo);
        da_tail(o, s0, s1, n0, n1, negm, l, 1 >= NT - 2, 64, qrow, hi);
        da_pack(pp, s0, s1); s0 = n0; s1 = n1;
        if (nd == 4) DA_WAITBAR_N(4); else DA_WAITBAR_N(2);
        DA_ROT();
    }
    int t = 1;
    for (; t + 4 < NT; t += 2) {
        {
            const size_t ko = (size_t)(t + 3) * 64 * 64;
            const DaDma dm{gk0, gk1, gv0, gv1, ko, (size_t)(t + 1) * 64, ldw + ks3, ldw + DA_VOFF + vs1};
            float mp;
            da_core_mid<true>(o, s0, s1, n0, n1, negm, pp, l, qfb, kfrag + ks1, vfrag + vsm, xo, mp, dm);
            da_tail(o, s0, s1, n0, n1, negm, l, false, 0, qrow, hi, true, mp);
            da_pack(pp, s0, s1);
            DA_WAITBAR_N(4);
            DA_ROT();
        }
        {
            const int u = t + 1;
            const size_t ko = (size_t)(u + 3) * 64 * 64;
            const DaDma dm{gk0, gk1, gv0, gv1, ko, (size_t)(u + 1) * 64, ldw + ks3, ldw + DA_VOFF + vs1};
            float mp;
            da_core_mid<true>(o, n0, n1, s0, s1, negm, pp, l, qfb, kfrag + ks1, vfrag + vsm, xo, mp, dm);
            da_tail(o, n0, n1, s0, s1, negm, l, false, 0, qrow, hi, true, mp);
            da_pack(pp, n0, n1);
            DA_WAITBAR_N(4);
            DA_ROT();
        }
    }
    for (; t < NT - 1; t += 2) {
        {
            int nd = 0;
            if (t + 3 < NT) { const size_t ko = (size_t)(t + 3) * 64 * 64; DA_DMA(gk0 + ko, ldw + ks3); DA_DMA(gk1 + ko, ldw + ks3 + DA_KB); nd += 2; }
            if (t + 1 < NT) { DA_DMA(gv0 + (size_t)(t + 1) * 64, ldw + DA_VOFF + vs1); DA_DMA(gv1 + (size_t)(t + 1) * 64, ldw + DA_VOFF + vs1 + 8192); nd += 2; }
            float mp;
            da_core_mid<false>(o, s0, s1, n0, n1, negm, pp, l, qfb, kfrag + ks1, vfrag + vsm, xo, mp, DaDma{});
            da_tail(o, s0, s1, n0, n1, negm, l, t + 1 >= NT - 2, (t + 1) * 64, qrow, hi, true, mp);
            da_pack(pp, s0, s1);
            if (nd == 4) DA_WAITBAR_N(4); else if (nd == 2) DA_WAITBAR_N(2); else DA_WAITBAR_N(0);
            DA_ROT();
        }
        {
            const int u = t + 1;
            int nd = 0;
            if (u + 3 < NT) { const size_t ko = (size_t)(u + 3) * 64 * 64; DA_DMA(gk0 + ko, ldw + ks3); DA_DMA(gk1 + ko, ldw + ks3 + DA_KB); nd += 2; }
            if (u + 1 < NT) { DA_DMA(gv0 + (size_t)(u + 1) * 64, ldw + DA_VOFF + vs1); DA_DMA(gv1 + (size_t)(u + 1) * 64, ldw + DA_VOFF + vs1 + 8192); nd += 2; }
            float mp;
            da_core_mid<false>(o, n0, n1, s0, s1, negm, pp, l, qfb, kfrag + ks1, vfrag + vsm, xo, mp, DaDma{});
            da_tail(o, n0, n1, s0, s1, negm, l, u + 1 >= NT - 2, (u + 1) * 64, qrow, hi, true, mp);
            da_pack(pp, n0, n1);
            if (nd == 4) DA_WAITBAR_N(4); else if (nd == 2) DA_WAITBAR_N(2); else DA_WAITBAR_N(0);
            DA_ROT();
        }
    }
    {
        da_core<false, true>(o, s0, s1, n0, n1, negm, pp, l, qfb, kfrag, vfrag + vsm, xo);
        da_pack(pp, s0, s1);
        DA_WAITBAR_N(0);
        const int vsl = (vsm == 2 * DA_VB) ? 0 : vsm + DA_VB;
        LAS unsigned char* vt = vfrag + vsl;
#pragma unroll
        for (int db = 0; db < 4; ++db)
#pragma unroll
            for (int s = 0; s < 4; ++s) {
                const bf16x8 va = *(const LAS bf16x8*)(vt + db * 32 * DA_PITCH + xo[s]);
                o[db] = __builtin_amdgcn_mfma_f32_32x32x16_bf16(va, __builtin_bit_cast(bf16x8, pp[s]), o[db], 0, 0, 0);
            }
    }
#undef DA_ROT
#undef DA_WAITBAR_N
#undef DA_DMA
    l += __shfl_xor(l, 32);
    const float inv = 1.0f / l;
    __syncthreads();
    LAS float* xb = (LAS float*)lds + (size_t)wq * 4096 + lane;
    if (comp == 1) {
#pragma unroll
        for (int db = 0; db < 4; ++db)
#pragma unroll
            for (int r = 0; r < 16; ++r) xb[(db * 16 + r) * 64] = o[db][r] * inv;
    }
    __syncthreads();
    if (comp == 0) {
        float ssq = 0.f;
#pragma unroll
        for (int db = 0; db < 4; ++db)
#pragma unroll
            for (int r = 0; r < 16; ++r) { const float d = o[db][r] * inv - lam * xb[(db * 16 + r) * 64]; o[db][r] = d; ssq += d * d; }
        ssq += __shfl_xor(ssq, 32);
        const float rstd = (1.0f - LAM_INIT) / sqrtf(ssq * (1.0f / 128.0f) + RMS_EPS);
        bf16* yp = Y + (size_t)qrow * DM + h * 128 + 4 * hi;
#pragma unroll
        for (int db = 0; db < 4; ++db)
#pragma unroll
            for (int g = 0; g < 4; ++g) {
                const f32x4 gg = *(const f32x4*)(g_subln + db * 32 + 8 * g + 4 * hi);
                u32x2 w; w.x = cvtpk(o[db][4 * g] * rstd * gg[0], o[db][4 * g + 1] * rstd * gg[1]); w.y = cvtpk(o[db][4 * g + 2] * rstd * gg[2], o[db][4 * g + 3] * rstd * gg[3]);
                *(u32x2*)(yp + db * 32 + 8 * g) = w;
            }
    }
    __syncthreads();
}

#define XB_TMO      128
#define XB_XCNT(j)  (256  + 64 * (j))
#define XB_XSUB(j)  (1280 + 64 * (j))
#define XB_XGEN(j)  (2304 + 64 * (j))
#define XB_TOP      3328
#define XB_TOPGEN   3392
#define XCD_BAR_WORDS 3456
#define XB_SPIN_CAP (1u << 18)

__device__ __forceinline__ unsigned xb_ld(unsigned* p)              { return __hip_atomic_load(p, __ATOMIC_RELAXED, __HIP_MEMORY_SCOPE_AGENT); }
__device__ __forceinline__ unsigned xb_add(unsigned* p, unsigned v) { return __hip_atomic_fetch_add(p, v, __ATOMIC_RELAXED, __HIP_MEMORY_SCOPE_AGENT); }
__device__ __forceinline__ unsigned xb_xcc_id() { return (unsigned)__builtin_amdgcn_s_getreg((3 << 11) | 20) & 0xFu; }
#define XB_SPIN(cond, bar) do { unsigned _sp = 0; while (cond) { __builtin_amdgcn_s_sleep(1); \
    if ((++_sp & 255u) == 0u) { if (xb_ld(&(bar)[XB_TMO])) break; if (_sp > XB_SPIN_CAP) { atomicAdd(&(bar)[XB_TMO], 1u); break; } } } } while (0)

struct XcdBarrier {
    unsigned* bar; unsigned x;
    volatile LAS unsigned* st;
};

__device__ __forceinline__ XcdBarrier xcd_barrier_post(unsigned* bar, volatile LAS unsigned* st) {
    XcdBarrier b; b.bar = bar; b.x = xb_xcc_id(); b.st = st;
    if (threadIdx.x == 0) (void)xb_add(&bar[XB_XCNT(b.x)], 1u);
    return b;
}
__device__ __forceinline__ void xcd_barrier_complete(unsigned* bar, unsigned x, unsigned& nloc, unsigned& nx) {
    const unsigned G = gridDim.x * gridDim.y * gridDim.z;
    unsigned sum, cnt, mine, sp = 0u;
    for (;;) {
        sum = 0u; cnt = 0u; mine = 0u;
#pragma unroll
        for (unsigned j = 0; j < 16; ++j) { const unsigned c = xb_ld(&bar[XB_XCNT(j)]); sum += c; cnt += (c > 0u) ? 1u : 0u; mine = (j == x) ? c : mine; }
        if (sum == G) break;
        __builtin_amdgcn_s_sleep(1);
        if ((++sp & 255u) == 0u) { if (xb_ld(&bar[XB_TMO])) break; if (sp > XB_SPIN_CAP) { atomicAdd(&bar[XB_TMO], 1u); break; } }
    }
    nloc = mine > 0u ? mine : 1u; nx = cnt > 0u ? cnt : 1u;
}

__device__ __forceinline__ void xcd_barrier(const XcdBarrier& b) {
    asm volatile("s_waitcnt vmcnt(0)" ::: "memory");
    __syncthreads();
    if (threadIdx.x == 0) {
        unsigned* bar = b.bar;
        __builtin_amdgcn_s_waitcnt(0);
        unsigned nloc = b.st[0], nx = b.st[1];
        if (nloc == 0u) { xcd_barrier_complete(bar, b.x, nloc, nx); b.st[0] = nloc; b.st[1] = nx; }
        const unsigned old = xb_add(&bar[XB_XSUB(b.x)], 1u);
        const unsigned gen = old / nloc;
        if (old + 1u == (gen + 1u) * nloc) {
            __builtin_amdgcn_fence(__ATOMIC_RELEASE, "agent");
            asm volatile("s_waitcnt vmcnt(0)" ::: "memory");
            const unsigned og = xb_add(&bar[XB_TOP], 1u);
            const unsigned tg = og / nx;
            if (og + 1u == (tg + 1u) * nx) xb_add(&bar[XB_TOPGEN], 1u);
            else XB_SPIN(xb_ld(&bar[XB_TOPGEN]) == tg, bar);
            __builtin_amdgcn_fence(__ATOMIC_ACQUIRE, "agent");
            xb_add(&bar[XB_XGEN(b.x)], 1u);
            asm volatile("s_waitcnt vmcnt(0)" ::: "memory");
        } else {
            XB_SPIN(xb_ld(&bar[XB_XGEN(b.x)]) == gen, bar);
            __builtin_amdgcn_fence(__ATOMIC_ACQUIRE, "agent");
            asm volatile("s_waitcnt vmcnt(0)" ::: "memory");
        }
    }
    __syncthreads();
}

#ifndef MK_N_LAUNCHES
#define MK_N_LAUNCHES 1
#endif
constexpr int N_PHASES = 9;
struct Args { const void* in[20]; float* out; unsigned char* ws; int ph_lo, ph_hi; };

__global__ void __launch_bounds__(512, 2) mega_fwd(Args args) {
    extern __shared__ __attribute__((aligned(16))) unsigned char lds_raw[];
    LAS unsigned char* lds = (LAS unsigned char*)lds_raw;
    cg::grid_group grid = cg::this_grid();
    const int G = gridDim.x, bx = blockIdx.x, NGW = G * 8;
#define PHASE_IDS int tid = threadIdx.x; asm volatile("" : "+v"(tid)); const int lane = tid & 63, wave = __builtin_amdgcn_readfirstlane(tid >> 6), gw = bx * 8 + wave; (void)lane; (void)gw;
    unsigned char* ws = args.ws;
    const float* x = (const float*)args.in[0]; const float* mem = (const float*)args.in[1]; const int* positions = (const int*)args.in[2];
    const float* g_mix = (const float*)args.in[3]; const float* w_in = (const float*)args.in[4];
    const float* lq1 = (const float*)args.in[5]; const float* lk1 = (const float*)args.in[6]; const float* lq2 = (const float*)args.in[7]; const float* lk2 = (const float*)args.in[8];
    const float* g_subln = (const float*)args.in[9]; const float* w_out = (const float*)args.in[10]; const float* g_cross = (const float*)args.in[11]; const float* g_mem = (const float*)args.in[12];
    const float* w_xq = (const float*)args.in[13]; const float* w_xkv = (const float*)args.in[14]; const float* w_xo = (const float*)args.in[15]; const float* g_mlp = (const float*)args.in[16];
    const float* w_up = (const float*)args.in[17]; const float* w_down = (const float*)args.in[18]; const float* g_final = (const float*)args.in[19];
    float* out = args.out;
    float* rstd0 = (float*)(ws + 196608); float* ssq1 = (float*)(ws + WS_SSQ1); float* ssq2 = (float*)(ws + WS_SSQ2); float* ssq3 = (float*)(ws + WS_SSQ3);
    float2* rope = (float2*)(ws + WS_ROPE);
    bf16* memn = (bf16*)(ws + WS_MEMN); bf16* kvb = (bf16*)(ws + WS_KV);
    bf16* Win_t = (bf16*)(ws + WS_WIN); bf16* Wout_t = (bf16*)(ws + WS_WOUT); bf16* Wxq_b = (bf16*)(ws + WS_WXQ); bf16* Wxkv_t = (bf16*)(ws + WS_WXKV); bf16* Wxo_t = (bf16*)(ws + WS_WXO);
    bf16* Wup_t = (bf16*)(ws + WS_WUP); bf16* Wdn_t = (bf16*)(ws + WS_WDN); bf16* Wqk_t = (bf16*)(ws + WS_WQK); bf16* Wvo_t = (bf16*)(ws + WS_WVO);
    bf16* XN = (bf16*)(ws + WS_XN); bf16* Pb = (bf16*)(ws + WS_P);
    bf16* Qd = (bf16*)(ws + WS_QD); bf16* Kd = (bf16*)(ws + WS_KD); bf16* Qs = (bf16*)(ws + WS_QS); bf16* Ks = (bf16*)(ws + WS_KS); bf16* Vt = (bf16*)(ws + WS_VT);
    bf16* Act = (bf16*)(ws + WS_ACT); bf16* Yb = (bf16*)(ws + WS_Y); bf16* H2b = (bf16*)(ws + WS_H2B); bf16* H1b = (bf16*)(ws + WS_H1B);

    const int lo = args.ph_lo, hi_ = args.ph_hi;
#define IN(k) (lo <= (k) && (k) < hi_)
    volatile LAS unsigned* bst = (volatile LAS unsigned*)(lds + 132096);
    if (threadIdx.x < 2) bst[threadIdx.x] = 0u;
    __syncthreads();
    XcdBarrier bar = xcd_barrier_post((unsigned*)(ws + WS_BAR), bst);
    if (lo < 0) grid.sync();
#define SEAM(k) do { if (IN(k) && IN((k) + 1)) xcd_barrier(bar); } while (0)

    if (IN(0)) {
        PHASE_IDS
        LAS float* scr = (LAS float*)(lds + wave * 16384);
        constexpr int I_IN = 16 * 96, I_OUT = 16 * 32, I_XKV = 16 * 64, I_XO = 16 * 32, I_UP = 16 * 128, I_DN = 64 * 32;
        for (int it = gw; it < I_XKV; it += NGW) p0_transpose_item(w_xkv, DM, 2 * DM, Wxkv_t, nullptr, scr, it, lane);
        for (int m = gw; m < MEML; m += NGW) rms_row_to_bf16(mem + (size_t)m * DM, g_mem, memn + (size_t)m * DM, lane);
        xcd_barrier(bar);
        const int NB = (G > 8) ? G - 8 : G;
        if (G > 8 && bx >= NB) {
            pg8::Gemm g{memn, Wxkv_t, MEML, 2 * DM, DM, DM, DM}; SmallOrder S{NB, 8, 8, bx};
            EpiPlain E{kvb, 2 * DM, 0, 0, nullptr, 1.0f};
            pg8::gemm_phase<EpiPlain, SmallOrder, true, true>(lds, g, S, E);
        }
        if (bx < NB) {
            const int gwl = bx * 8 + wave, NGWL = NB * 8;
            constexpr int NITEMS = I_IN + I_OUT + I_XO + I_UP + I_DN;
            for (int it = gwl; it < NITEMS; it += NGWL) {
                int r = it;
                if (r < I_IN) { p0_transpose_item(w_in, DM, INC, Win_t, g_mix, scr, r, lane); continue; } r -= I_IN;
                if (r < I_OUT) { p0_transpose_item(w_out, DM, DM, Wout_t, nullptr, scr, r, lane); continue; } r -= I_OUT;
                if (r < I_XO) { p0_transpose_item(w_xo, DM, DM, Wxo_t, nullptr, scr, r, lane); continue; } r -= I_XO;
                if (r < I_UP) { p0_transpose_item(w_up, DM, FF, Wup_t, g_mlp, scr, r, lane); continue; } r -= I_UP;
                p0_transpose_item(w_down, FF, DM, Wdn_t, nullptr, scr, r, lane);
            }
            const int gt = bx * 512 + tid, NGT = NB * 512;
            for (int i = gt; i < DM * DM / 4; i += NGT) { const f32x4 v = __builtin_nontemporal_load((const f32x4*)w_xq + i); u32x2 w; w.x = cvtpk(v[0], v[1]); w.y = cvtpk(v[2], v[3]); ((u32x2*)Wxq_b)[i] = w; }
            for (int i = gt; i < SEQ * 8; i += NGT) {
                const int row = i >> 3, k = i & 7;
                const float inv_freq = (float)pow(500000.0, -(double)k / 8.0);
                const float ang = (float)positions[row] * inv_freq;
                rope[i] = make_float2((float)cos((double)ang), (float)sin((double)ang));
            }
            for (int i = gt; i < SEQ; i += NGT) { ssq1[i] = 0.f; ssq2[i] = 0.f; ssq3[i] = 0.f; }
            for (int m = gwl; m < SEQ; m += NGWL) row_to_bf16_rstd(x + (size_t)m * DM, XN + (size_t)m * DM, rstd0 + m, lane);
        }
    }
    SEAM(0);
    if (IN(1)) {
        pg8::Gemm g{XN, Win_t, SEQ, INC, DM, DM, DM}; pg8::StaticOrder S; S.init(SEQ, INC, G, bx);
        EpiInProj E{Qd, Kd, Qs, Ks, Vt, rope, rstd0};
        pg8::gemm_phase<EpiInProj, pg8::StaticOrder, true, true>(lds, g, S, E);
    }
    SEAM(1);
    if (IN(2)) {
        PHASE_IDS
#pragma unroll 1
        for (int j = 0; j < 8; ++j) {
            const int hh = j & 3; const bool qk = j < 4;
            pg8::Gemm g{qk ? kvb + hh * 256 : Wxo_t + hh * 256, qk ? Wxq_b + hh * 256 : kvb + DM + hh * 256, qk ? 256 : DM, qk ? DM : 256, 256, qk ? 2 * DM : DM, qk ? DM : 2 * DM};
            SmallOrder S{4 * j, qk ? 4 : 1, 4, bx};
            EpiPlain E{qk ? Wqk_t : Wvo_t, DM, qk ? hh * 256 : 0, qk ? 0 : hh * 256, qk ? g_cross : nullptr, qk ? 0.0625f : 1.0f};
            pg8::gemm_phase<EpiPlain, SmallOrder, true, true>(lds, g, S, E);
        }
        for (int uu = gw; uu < 8 * (SEQ / 32); uu += NGW) sb_wave_unit(uu & 7, uu >> 3, Qs, Ks, Vt, Yb, lane);
        float lam;
        { const float a = wave_sum(lq1[lane] * lk1[lane]), b = wave_sum(lq2[lane] * lk2[lane]); lam = expf(a) - expf(b) + LAM_INIT; }
        __syncthreads();
        for (int p = bx; p < 256; p += G) {
            const int h = p & 3, pp = p >> 2;
#pragma unroll 1
            for (int k = 0; k < 2; ++k) diff_unit(h, k ? pp : 127 - pp, Qd, Kd, Vt, Yb, g_subln, lam, lds);
        }
    }
    SEAM(2);
    if (IN(3)) {
        pg8::Gemm g{Yb, Wout_t, SEQ, DM, DM, DM, DM}; pg8::StaticOrder S; S.init(SEQ, DM, G, bx);
        EpiRes<true> E{XN, H1b, ssq1};
        pg8::gemm_phase<EpiRes<true>, pg8::StaticOrder, true, true>(lds, g, S, E);
    }
    SEAM(3);
    if (IN(4)) {
        pg8::Gemm g{H1b, Wqk_t, SEQ, DM, DM, DM, DM}; pg8::StaticOrder S; S.init(SEQ, DM, G, bx);
        EpiCrossSoftmax E{ssq1, Pb};
        pg8::gemm_phase<EpiCrossSoftmax, pg8::StaticOrder, false, true>(lds, g, S, E);
    }
    SEAM(4);
    if (IN(5)) {
        pg8::Gemm g{Pb, Wvo_t, SEQ, DM, DM, DM, DM}; pg8::StaticOrder S; S.init(SEQ, DM, G, bx);
        EpiRes<true> E{H1b, H2b, ssq2};
        pg8::gemm_phase<EpiRes<true>, pg8::StaticOrder, true, true>(lds, g, S, E);
    }
    SEAM(5);
    if (IN(6)) {
        pg8::Gemm g{H2b, Wup_t, SEQ, FF, DM, DM, DM}; pg8::StaticOrder S; S.init(SEQ, FF, G, bx);
        EpiUp E{ssq2, Act};
        pg8::gemm_phase<EpiUp, pg8::StaticOrder, true, true>(lds, g, S, E);
    }
    SEAM(6);
    const bool fuse_final = (G == 256);
    if (IN(7)) {
        pg8::Gemm g{Act, Wdn_t, SEQ, DM, FF, FF, FF}; pg8::StaticOrder S; S.init(SEQ, DM, G, bx);
        if (fuse_final) {
            EpiResFinal E{H2b, out, ssq3, (unsigned*)(ws + WS_BAR + 14336), g_final};
            pg8::gemm_phase<EpiResFinal, pg8::StaticOrder, false, true>(lds, g, S, E);
        } else {
            EpiResF32 E{H2b, out, ssq3};
            pg8::gemm_phase<EpiResF32, pg8::StaticOrder, true, true>(lds, g, S, E);
        }
    }
    if (!fuse_final) {
        SEAM(7);
        if (IN(8)) {
            PHASE_IDS
            for (int m = gw; m < SEQ; m += NGW) {
                const float rstd = 1.0f / sqrtf(ssq3[m] * (1.0f / DM) + RMS_EPS);
                f32x4* orow = (f32x4*)(out + (size_t)m * DM) + lane; const f32x4* gr = (const f32x4*)g_final + lane;
#pragma unroll
                for (int j = 0; j < 4; ++j) { const f32x4 v = orow[64 * j]; orow[64 * j] = v * rstd * gr[64 * j]; }
            }
        }
    }
#undef IN
#undef SEAM
}

extern "C" void kernel_launch(void* const* d_in, const int* in_sizes, int n_in, void* d_out, int out_size, void* d_ws, size_t ws_size, hipStream_t stream) {
    static int grid = 0;
    if (grid == 0) {
        if (n_in != 20 || out_size != SEQ * DM || ws_size < WS_END) { fprintf(stderr, "kernel_launch: unexpected shapes (n_in %d out %d ws %zu)\n", n_in, out_size, ws_size); grid = -1; return; }
        int dev = 0, cus = 0, per_cu = 0;
        (void)hipGetDevice(&dev); (void)hipDeviceGetAttribute(&cus, hipDeviceAttributeMultiprocessorCount, dev);
        if (hipFuncSetAttribute((const void*)mega_fwd, hipFuncAttributeMaxDynamicSharedMemorySize, LDS_BYTES) != hipSuccess) { fprintf(stderr, "kernel_launch: hipFuncSetAttribute failed\n"); grid = -1; return; }
        if (hipOccupancyMaxActiveBlocksPerMultiprocessor(&per_cu, (const void*)mega_fwd, 512, LDS_BYTES) != hipSuccess || per_cu < 1) per_cu = 1;
        (void)hipGetLastError();
        grid = cus * per_cu;
        fprintf(stderr, "kernel_launch: grid %d (cus %d x %d)\n", grid, cus, per_cu);
    }
    if (grid < 0) return;
    Args a{};
    for (int i = 0; i < 20; ++i) a.in[i] = d_in[i];
    a.out = (float*)d_out; a.ws = (unsigned char*)d_ws;
#if MK_N_LAUNCHES == 1
    if (hipMemsetAsync((char*)d_ws + WS_BAR, 0, BAR_BYTES, stream) != hipSuccess) { fprintf(stderr, "kernel_launch: hipMemsetAsync failed\n"); return; }
    a.ph_lo = 0; a.ph_hi = N_PHASES;
    void* kargs[] = {&a};
    hipError_t e = hipLaunchCooperativeKernel((const void*)mega_fwd, dim3(grid), dim3(512), kargs, LDS_BYTES, stream);
    if (e != hipSuccess) fprintf(stderr, "cooperative launch failed: %s (grid %d)\n", hipGetErrorString(e), grid);
#else
    for (int p = 0; p < N_PHASES; ++p) { a.ph_lo = p; a.ph_hi = p + 1; hipLaunchKernelGGL(mega_fwd, dim3(grid), dim3(512), LDS_BYTES, stream, a); }
#endif
}
```

```cpp
#include <hip/hip_runtime.h>
#include <hip/hip_cooperative_groups.h>
#include <cstdio>
#include <cstdint>
namespace cg = cooperative_groups;
namespace pg8 {
#define PG8_LAS __attribute__((address_space(3)))
typedef unsigned short bf16_t;
typedef short bf16x8 __attribute__((ext_vector_type(8)));
typedef float f32x4 __attribute__((ext_vector_type(4)));
typedef unsigned u32x4 __attribute__((ext_vector_type(4)));
constexpr int BM = 256, BK = 64, HALF = 128, HTB = HALF * BK * 2  , STAGE_BYTES = 8 * HTB, NXCD = 8, WGM = 8;

__host__ __device__ __forceinline__ int lds_byte(int r, int c) { const int st = (r >> 4) * 2 + (c >> 5), rr = r & 15, cc = c & 31, ob = rr * 64 + cc * 2; return st * 1024 + (ob ^ (((ob >> 9) & 1) << 5)); }
__host__ __device__ __forceinline__ void stage_rc(int b, int& R, int& C) { const int st = b / 1024, sb = b % 1024, swz = sb ^ (((sb >> 9) & 1) << 5); R = (st >> 1) * 16 + swz / 64; C = (st & 1) * 32 + (swz % 64) / 2; }
__host__ __device__ __forceinline__ int perm32(int rho) { const int n = rho >> 4, i = rho & 15; return 8 * (i >> 2) + 4 * n + (i & 3); }

struct Unit { int pm, pn; };
struct Gemm { const bf16_t* A; const bf16_t* Bt; int M, N, K, lda, ldb; };

struct StaticOrder {
    int nM, nN, nwg, G, c;
    __host__ __device__ void init(int M, int N, int G_, int c_) { nM = M / BM; nN = N / BM; nwg = nM * nN; G = G_; c = c_; }
    __host__ __device__ bool next(int i, Unit& u) const {
        const long L = (long)i * G + c; if (L >= nwg) return false;
        int wgid = (int)L; { const int q = nwg / NXCD, r = nwg % NXCD, xcd = wgid % NXCD, off = wgid / NXCD; wgid = (xcd < r ? xcd * (q + 1) : r * (q + 1) + (xcd - r) * q) + off; }
        const int nig = WGM * nN, gid = wgid / nig, fm = gid * WGM, gsz = (nM - fm) < WGM ? (nM - fm) : WGM;
        u.pm = fm + ((wgid % nig) % gsz); u.pn = (wgid % nig) / gsz; return true;
    }
    __device__ __forceinline__ void a_ready(const Unit&) const {}
    __device__ __forceinline__ void done(const Unit&) const {}
};

__device__ __forceinline__ unsigned cvt_pk_bf16(float lo, float hi) { unsigned r; asm volatile("v_cvt_pk_bf16_f32 %0, %1, %2" : "=v"(r) : "v"(lo), "v"(hi)); return r; }
typedef float f32x2 __attribute__((ext_vector_type(2)));
template <class Epi, class Sched, bool ALIGN_EPI = false, bool SP2 = false>
__device__ __forceinline__ void gemm_phase(PG8_LAS unsigned char* lds, const Gemm g, const Sched& S, const Epi& E) {
    int tid = threadIdx.x; asm volatile("" : "+v"(tid));
    const int wid = __builtin_amdgcn_readfirstlane(tid >> 6), lane = tid & 63, wr = wid >> 2, wc = wid & 3, fr = lane & 15, fq = lane >> 4;
    const int K = g.K, nt = K / BK;
    unsigned voffA[2], voffB[2];
#pragma unroll
    for (int i = 0; i < 2; ++i) { int R, C; stage_rc(tid * 16 + i * 8192, R, C); const int Rb = Epi::PERM ? ((R & ~31) + perm32(R & 31)) : R;
        voffA[i] = (unsigned)(R * g.lda + C) * 2u; voffB[i] = (unsigned)(Rb * g.ldb + C) * 2u; }
    const size_t kstep = (size_t)(BK * 2);
    const size_t hstepA = (size_t)HALF * g.lda * 2, hstepB = (size_t)HALF * g.ldb * 2;
    const size_t tstepA = 2 * hstepA, tstepB = 2 * hstepB;
    const unsigned ldsw = (unsigned)wid * 1024u;
    const int aoff = lds_byte(wr * 64 + fr, fq * 8), boff = lds_byte(wc * 32 + fr, fq * 8);
#define PG8_SA(b, h) (((b) * 2 + (h)) * HTB)
#define PG8_SB(b, h) ((4 + (b) * 2 + (h)) * HTB)
#define PG8_STAGE(bufoff, gbase, voff) do { _Pragma("unroll") for (int _i = 0; _i < 2; ++_i) \
        __builtin_amdgcn_global_load_lds((const unsigned*)((const char*)(gbase) + (voff)[_i]), (PG8_LAS unsigned*)(lds + (bufoff) + ldsw + _i * 8192), 16, 0, 0); } while (0)
#define PG8_LDA(dst, b, h) do { _Pragma("unroll") for (int m = 0; m < 4; ++m) _Pragma("unroll") for (int k = 0; k < 2; ++k) dst[m][k] = *(const PG8_LAS bf16x8*)(lds + PG8_SA(b, h) + aoff + m * 2048 + k * 1024); } while (0)
#define PG8_LDB(dst, b, h) do { _Pragma("unroll") for (int n = 0; n < 2; ++n) _Pragma("unroll") for (int k = 0; k < 2; ++k) dst[n][k] = *(const PG8_LAS bf16x8*)(lds + PG8_SB(b, h) + boff + n * 2048 + k * 1024); } while (0)
#define PG8_MMA(ai, bj, At, Bt) do { __builtin_amdgcn_s_setprio(1); _Pragma("unroll") for (int m = 0; m < 4; ++m) _Pragma("unroll") for (int n = 0; n < 2; ++n) _Pragma("unroll") for (int k = 0; k < 2; ++k) \
        acc[ai][bj][m][n] = __builtin_amdgcn_mfma_f32_16x16x32_bf16(Bt[n][k], At[m][k], acc[ai][bj][m][n], 0, 0, 0); __builtin_amdgcn_s_setprio(0); } while (0)
#define PG8_WAIT_V(n) asm volatile("s_waitcnt vmcnt(" #n ")" ::: "memory")
#define PG8_WAIT_L(n) asm volatile("s_waitcnt lgkmcnt(" #n ")" ::: "memory")
#define PG8_BAR __builtin_amdgcn_s_barrier()
#define PG8_SCHED __builtin_amdgcn_sched_barrier(0)
    Unit cur, nxt; int ui = 0;
    if (!S.next(0, cur)) return;
    f32x4 acc[2][2][4][2];
#pragma unroll
    for (int a = 0; a < 2; ++a)
#pragma unroll
        for (int b = 0; b < 2; ++b)
#pragma unroll
            for (int m = 0; m < 4; ++m)
#pragma unroll
                for (int n = 0; n < 2; ++n) acc[a][b][m][n] = (f32x4){0.f, 0.f, 0.f, 0.f};
    bf16x8 At[4][2], B0[2][2], B1[2][2];
    const char* cA = (const char*)g.A + (size_t)cur.pm * tstepA; const char* cB = (const char*)g.Bt + (size_t)cur.pn * tstepB;
    S.a_ready(cur);
    if constexpr (SP2) {
        PG8_STAGE(PG8_SB(0, 0), cB, voffB); PG8_STAGE(PG8_SB(0, 1), cB + hstepB, voffB); PG8_STAGE(PG8_SA(0, 0), cA, voffA); PG8_STAGE(PG8_SA(0, 1), cA + hstepA, voffA);
        if (wr == 1) PG8_BAR;
        PG8_WAIT_V(2); PG8_BAR;
        PG8_STAGE(PG8_SB(1, 0), cB + kstep, voffB); PG8_STAGE(PG8_SA(1, 0), cA + kstep, voffA); PG8_STAGE(PG8_SB(1, 1), cB + hstepB + kstep, voffB);
        PG8_WAIT_V(6); PG8_BAR;
    } else {
        PG8_STAGE(PG8_SB(0, 0), cB, voffB); PG8_STAGE(PG8_SA(0, 0), cA, voffA); PG8_STAGE(PG8_SB(0, 1), cB + hstepB, voffB); PG8_STAGE(PG8_SA(0, 1), cA + hstepA, voffA);
        if (wr == 1) PG8_BAR;
        PG8_WAIT_V(4); PG8_BAR;
        PG8_STAGE(PG8_SB(1, 0), cB + kstep, voffB); PG8_STAGE(PG8_SA(1, 0), cA + kstep, voffA); PG8_STAGE(PG8_SB(1, 1), cB + hstepB + kstep, voffB);
        PG8_WAIT_V(6); PG8_BAR;
    }
    for (;;) {
        const bool has_next = S.next(ui + 1, nxt);
        const char* nA = has_next ? (const char*)g.A + (size_t)nxt.pm * tstepA : cA; const char* nB = has_next ? (const char*)g.Bt + (size_t)nxt.pn * tstepB : cB;
        for (int t = 0; t < nt; t += 2) {
            const bool last = (t == nt - 2);
            const char* a1 = cA + (size_t)(t + 1) * kstep;
            const char* a2 = last ? nA : cA + (size_t)(t + 2) * kstep; const char* b2 = last ? nB : cB + (size_t)(t + 2) * kstep;
            const char* a3 = a2 + kstep; const char* b3 = b2 + kstep;
            if (last && has_next) S.a_ready(nxt);
            if constexpr (SP2) {
            PG8_LDB(B0, 0, 0); PG8_LDB(B1, 0, 1); PG8_SCHED; PG8_LDA(At, 0, 0); PG8_STAGE(PG8_SA(1, 1), a1 + hstepA, voffA);
            PG8_WAIT_V(8); PG8_WAIT_L(0); PG8_BAR; PG8_MMA(0, 0, At, B0); PG8_MMA(0, 1, At, B1); PG8_BAR; PG8_SCHED;
            PG8_LDA(At, 0, 1); PG8_STAGE(PG8_SB(0, 0), b2, voffB); PG8_STAGE(PG8_SB(0, 1), b2 + hstepB, voffB); PG8_STAGE(PG8_SA(0, 0), a2, voffA);
            PG8_WAIT_V(8); PG8_WAIT_L(0); PG8_BAR; PG8_MMA(1, 0, At, B0); PG8_MMA(1, 1, At, B1); PG8_BAR; PG8_SCHED;
            PG8_LDB(B0, 1, 0); PG8_LDB(B1, 1, 1); PG8_SCHED; PG8_LDA(At, 1, 0); PG8_STAGE(PG8_SA(0, 1), a2 + hstepA, voffA);
            PG8_WAIT_V(8); PG8_WAIT_L(0); PG8_BAR; PG8_MMA(0, 0, At, B0); PG8_MMA(0, 1, At, B1); PG8_BAR; PG8_SCHED;
            PG8_LDA(At, 1, 1); PG8_STAGE(PG8_SB(1, 0), b3, voffB); PG8_STAGE(PG8_SB(1, 1), b3 + hstepB, voffB); PG8_STAGE(PG8_SA(1, 0), a3, voffA);
            PG8_WAIT_V(8); PG8_WAIT_L(0); PG8_BAR; PG8_MMA(1, 0, At, B0); PG8_MMA(1, 1, At, B1); PG8_BAR; PG8_SCHED;
            } else {
            PG8_LDB(B0, 0, 0); PG8_SCHED; PG8_LDA(At, 0, 0); PG8_STAGE(PG8_SA(1, 1), a1 + hstepA, voffA);
            PG8_WAIT_L(8); PG8_BAR; PG8_WAIT_L(0); PG8_MMA(0, 0, At, B0); PG8_BAR; PG8_SCHED;
            PG8_LDB(B1, 0, 1); PG8_STAGE(PG8_SB(0, 0), b2, voffB);
            PG8_BAR; PG8_WAIT_L(0); PG8_MMA(0, 1, At, B1); PG8_BAR;
            PG8_LDA(At, 0, 1); PG8_STAGE(PG8_SA(0, 0), a2, voffA);
            PG8_BAR; PG8_WAIT_L(0); PG8_MMA(1, 0, At, B0); PG8_BAR; PG8_SCHED;
            PG8_STAGE(PG8_SB(0, 1), b2 + hstepB, voffB);
            PG8_WAIT_V(6); PG8_BAR; PG8_MMA(1, 1, At, B1); PG8_BAR;
            PG8_LDB(B0, 1, 0); PG8_SCHED; PG8_LDA(At, 1, 0); PG8_STAGE(PG8_SA(0, 1), a2 + hstepA, voffA);
            PG8_WAIT_L(8); PG8_BAR; PG8_WAIT_L(0); PG8_MMA(0, 0, At, B0); PG8_BAR; PG8_SCHED;
            PG8_LDB(B1, 1, 1); PG8_STAGE(PG8_SB(1, 0), b3, voffB);
            PG8_BAR; PG8_WAIT_L(0); PG8_MMA(0, 1, At, B1); PG8_BAR;
            PG8_LDA(At, 1, 1); PG8_STAGE(PG8_SA(1, 0), a3, voffA);
            PG8_BAR; PG8_WAIT_L(0); PG8_MMA(1, 0, At, B0); PG8_BAR; PG8_SCHED;
            PG8_STAGE(PG8_SB(1, 1), b3 + hstepB, voffB);
            PG8_WAIT_V(6); PG8_BAR; PG8_MMA(1, 1, At, B1); PG8_BAR;
            }
        }
        if constexpr (ALIGN_EPI) { if (wr == 0) PG8_BAR; }
        if constexpr (!Epi::AFTER_DRAIN) { E(acc, cur, wr, wc, fr, fq); S.done(cur); }
        if (!has_next) break;
#pragma unroll
        for (int a = 0; a < 2; ++a)
#pragma unroll
            for (int b = 0; b < 2; ++b)
#pragma unroll
                for (int m = 0; m < 4; ++m)
#pragma unroll
                    for (int n = 0; n < 2; ++n) acc[a][b][m][n] = (f32x4){0.f, 0.f, 0.f, 0.f};
        cur = nxt; cA = nA; cB = nB; ++ui;
        if constexpr (ALIGN_EPI) { if (wr == 1) PG8_BAR; }
    }
    PG8_WAIT_V(0);
    if constexpr (!ALIGN_EPI) { if (wr == 0) PG8_BAR; }
    PG8_BAR;
    if constexpr (Epi::AFTER_DRAIN) { E.fused(acc, cur, wr, wc, fr, fq, lds, wid, lane); S.done(cur); }
#undef PG8_SA
#undef PG8_SB
#undef PG8_STAGE
#undef PG8_LDA
#undef PG8_LDB
#undef PG8_MMA
#undef PG8_WAIT_V
#undef PG8_WAIT_L
#undef PG8_BAR
#undef PG8_SCHED
}
}

constexpr int SEQ = 16384, DM = 1024, INC = 3072, FF = 4096, MEML = 256;
constexpr float RMS_EPS = 1e-6f;
constexpr float LOG2E = 1.4426950408889634f;
constexpr float LAM_INIT = 0.2f;

#define LAS __attribute__((address_space(3)))
typedef unsigned short bf16;
typedef short bf16x8 __attribute__((ext_vector_type(8)));
typedef float f32x4 __attribute__((ext_vector_type(4)));
typedef float f32x16 __attribute__((ext_vector_type(16)));
typedef unsigned u32x4 __attribute__((ext_vector_type(4)));
typedef unsigned u32x2 __attribute__((ext_vector_type(2)));

constexpr size_t MiB = 1u << 20;
constexpr size_t WS_SSQ1 = 0, WS_SSQ2 = 65536, WS_SSQ3 = 131072, WS_ROPE = 262144;
constexpr size_t WS_MEMN = 1536 * 1024, WS_KV = 2 * MiB, WS_BAR = 3 * MiB, BAR_BYTES = 16384;
constexpr size_t WS_WIN = 4 * MiB, WS_WOUT = 10 * MiB, WS_WXQ = 12 * MiB, WS_WXKV = 14 * MiB, WS_WXO = 18 * MiB, WS_WUP = 20 * MiB, WS_WDN = 28 * MiB, WS_WQK = 36 * MiB, WS_WVO = 38 * MiB;
constexpr size_t WS_XN = 40 * MiB, WS_P = 40 * MiB;
constexpr size_t WS_QD = 72 * MiB, WS_KD = 88 * MiB, WS_QS = 104 * MiB, WS_KS = 120 * MiB, WS_VT = 136 * MiB;
constexpr size_t WS_ACT = 40 * MiB;
constexpr size_t WS_Y = 168 * MiB, WS_H2B = 168 * MiB, WS_H1B = 200 * MiB, WS_END = 232 * MiB;

constexpr int LDS_BYTES = 136 * 1024;

__device__ __forceinline__ unsigned cvtpk(float lo, float hi) { unsigned r; asm volatile("v_cvt_pk_bf16_f32 %0, %1, %2" : "=v"(r) : "v"(lo), "v"(hi)); return r; }
__device__ __forceinline__ unsigned short f2bf(float f) { return (unsigned short)(cvtpk(f, f) & 0xffffu); }
__device__ __forceinline__ float wave_sum(float v) {
#pragma unroll
    for (int o = 1; o < 64; o <<= 1) v += __shfl_xor(v, o);
    return v;
}
__device__ __forceinline__ int crow(int r, int hi) { return (r & 3) + 8 * (r >> 2) + 4 * hi; }

using pg8::Unit;

struct EpiInProj {
    static constexpr bool PERM = true, AFTER_DRAIN = false;
    bf16 *Qd, *Kd, *Qs, *Ks, *Vt; const float2* rope; const float* rstd0;
    __device__ __forceinline__ void operator()(const f32x4 (&acc)[2][2][4][2], const Unit& u, int wr, int wc, int fr, int fq) const {
        const int region = u.pn >> 1;
        const int row0 = u.pm * 256 + wr * 64 + fr;
        if (region == 2 || region == 5) {
            const int vrow0 = (region == 5 ? 512 : 0) + (u.pn & 1) * 256 + wc * 32 + 8 * fq;
#pragma unroll
            for (int ai = 0; ai < 2; ++ai)
#pragma unroll
                for (int m = 0; m < 4; ++m) {
                    const int row = row0 + ai * 128 + m * 16; const int x = row & 15;
                    const int pos = (row & ~15) | (x & 3) | ((x & 4) << 1) | ((x & 8) >> 1);
                    const float rs = rstd0[row];
#pragma unroll
                    for (int bj = 0; bj < 2; ++bj)
#pragma unroll
                        for (int n = 0; n < 2; ++n)
#pragma unroll
                            for (int e = 0; e < 4; ++e) Vt[(size_t)(vrow0 + bj * 128 + 4 * n + e) * SEQ + pos] = f2bf(acc[ai][bj][m][n][e] * rs);
                }
        } else {
            bf16* base = region == 0 ? Qd : region == 1 ? Kd : region == 3 ? Qs : Ks;
            const float sc = region == 0 ? 0.125f * LOG2E : region == 3 ? 0.125f : 1.f;
            const bool rope_on = (region < 2) && ((wc & 1) == 0);
            const int d0 = (wc & 1) * 32 + 8 * fq;
#pragma unroll
            for (int ai = 0; ai < 2; ++ai)
#pragma unroll
                for (int m = 0; m < 4; ++m) {
                    const int row = row0 + ai * 128 + m * 16;
                    const float scr_ = sc * rstd0[row];
#pragma unroll
                    for (int bj = 0; bj < 2; ++bj) {
                        const int head = (u.pn & 1) * 4 + 2 * bj + (wc >> 1);
                        f32x4 v0 = acc[ai][bj][m][0], v1 = acc[ai][bj][m][1];
                        if (rope_on) {
                            f32x4 p0, p1;
#pragma unroll
                            for (int e = 0; e < 4; ++e) { p0[e] = __shfl_xor(v0[e], 16); p1[e] = __shfl_xor(v1[e], 16); }
                            if (fq < 2) {
                                const float sg = fq == 0 ? -1.f : 1.f;
                                const float2* rp = rope + (size_t)row * 8;
#pragma unroll
                                for (int e = 0; e < 4; ++e) {
                                    const float2 c0 = rp[e], c1 = rp[4 + e];
                                    v0[e] = v0[e] * c0.x + sg * p0[e] * c0.y;
                                    v1[e] = v1[e] * c1.x + sg * p1[e] * c1.y;
                                }
                            }
                        }
                        u32x4 w; w.x = cvtpk(v0[0] * scr_, v0[1] * scr_); w.y = cvtpk(v0[2] * scr_, v0[3] * scr_); w.z = cvtpk(v1[0] * scr_, v1[1] * scr_); w.w = cvtpk(v1[2] * scr_, v1[3] * scr_);
                        *(u32x4*)(base + ((size_t)head * SEQ + row) * 64 + d0) = w;
                    }
                }
        }
    }
};

__device__ __forceinline__ f32x4 bf4_to_f32(u32x2 w) { f32x4 r; r[0] = __uint_as_float(w.x << 16); r[1] = __uint_as_float(w.x & 0xffff0000u); r[2] = __uint_as_float(w.y << 16); r[3] = __uint_as_float(w.y & 0xffff0000u); return r; }
template <bool BASE_BF16> struct EpiRes {
    static constexpr bool PERM = true, AFTER_DRAIN = false;
    const void* base; bf16* outb; float* ssq;
    __device__ __forceinline__ void operator()(const f32x4 (&acc)[2][2][4][2], const Unit& u, int wr, int wc, int fr, int fq) const {
        const int col0 = u.pn * 256 + wc * 32 + 8 * fq;
#pragma unroll
        for (int ai = 0; ai < 2; ++ai)
#pragma unroll
            for (int m = 0; m < 4; ++m) {
                const int row = u.pm * 256 + ai * 128 + wr * 64 + m * 16 + fr; const size_t off = (size_t)row * DM + col0; float s = 0.f;
#pragma unroll
                for (int bj = 0; bj < 2; ++bj) {
                    f32x4 b0, b1;
                    if (BASE_BF16) { const u32x4 w = __builtin_nontemporal_load((const u32x4*)((const bf16*)base + off + bj * 128)); u32x2 lo, hi; lo.x = w.x; lo.y = w.y; hi.x = w.z; hi.y = w.w; b0 = bf4_to_f32(lo); b1 = bf4_to_f32(hi); }
                    else { b0 = __builtin_nontemporal_load((const f32x4*)((const float*)base + off + bj * 128)); b1 = __builtin_nontemporal_load((const f32x4*)((const float*)base + off + bj * 128 + 4)); }
                    const f32x4 o0 = b0 + acc[ai][bj][m][0], o1 = b1 + acc[ai][bj][m][1];
                    s += ((o0[0] * o0[0] + o0[1] * o0[1]) + (o0[2] * o0[2] + o0[3] * o0[3])) + ((o1[0] * o1[0] + o1[1] * o1[1]) + (o1[2] * o1[2] + o1[3] * o1[3]));
                    u32x4 wo; wo.x = cvtpk(o0[0], o0[1]); wo.y = cvtpk(o0[2], o0[3]); wo.z = cvtpk(o1[0], o1[1]); wo.w = cvtpk(o1[2], o1[3]);
                    *(u32x4*)(outb + off + bj * 128) = wo;
                }
                s += __shfl_xor(s, 16); s += __shfl_xor(s, 32);
                if (fq == 0) atomicAdd(ssq + row, s);
            }
    }
};

struct EpiResF32 {
    static constexpr bool PERM = false, AFTER_DRAIN = false;
    const bf16* base; float* out; float* ssq;
    __device__ __forceinline__ void operator()(const f32x4 (&acc)[2][2][4][2], const Unit& u, int wr, int wc, int fr, int fq) const {
        const int col0 = u.pn * 256 + wc * 32 + 4 * fq;
#pragma unroll
        for (int ai = 0; ai < 2; ++ai)
#pragma unroll
            for (int m = 0; m < 4; ++m) {
                const int row = u.pm * 256 + ai * 128 + wr * 64 + m * 16 + fr; const size_t off = (size_t)row * DM + col0; float s = 0.f;
#pragma unroll
                for (int bj = 0; bj < 2; ++bj)
#pragma unroll
                    for (int n = 0; n < 2; ++n) {
                        const f32x4 o = bf4_to_f32(*(const u32x2*)(base + off + bj * 128 + n * 16)) + acc[ai][bj][m][n];
                        *(f32x4*)(out + off + bj * 128 + n * 16) = o; s += (o[0] * o[0] + o[1] * o[1]) + (o[2] * o[2] + o[3] * o[3]);
                    }
                s += __shfl_xor(s, 16); s += __shfl_xor(s, 32);
                if (fq == 0) atomicAdd(ssq + row, s);
            }
    }
};

struct EpiPlain {
    static constexpr bool PERM = true, AFTER_DRAIN = false;
    bf16* O; int ldc, row_off, col_off; const float* colscale; float scale;
    __device__ __forceinline__ void operator()(const f32x4 (&acc)[2][2][4][2], const Unit& u, int wr, int wc, int fr, int fq) const {
#pragma unroll
        for (int bj = 0; bj < 2; ++bj) {
            const int col = u.pn * 256 + bj * 128 + wc * 32 + 8 * fq;
            f32x4 c0 = (f32x4){scale, scale, scale, scale}, c1 = c0;
            if (colscale) { c0 = *(const f32x4*)(colscale + col) * scale; c1 = *(const f32x4*)(colscale + col + 4) * scale; }
#pragma unroll
            for (int ai = 0; ai < 2; ++ai)
#pragma unroll
                for (int m = 0; m < 4; ++m) {
                    const int row = row_off + u.pm * 256 + ai * 128 + wr * 64 + m * 16 + fr;
                    const f32x4 v0 = acc[ai][bj][m][0] * c0, v1 = acc[ai][bj][m][1] * c1;
                    u32x4 w; w.x = cvtpk(v0[0], v0[1]); w.y = cvtpk(v0[2], v0[3]); w.z = cvtpk(v1[0], v1[1]); w.w = cvtpk(v1[2], v1[3]);
                    *(u32x4*)(O + (size_t)row * ldc + col_off + col) = w;
                }
        }
    }
};

struct EpiUp {
    static constexpr bool PERM = true, AFTER_DRAIN = false;
    const float* ssq; bf16* O;
    __device__ __forceinline__ void operator()(const f32x4 (&acc)[2][2][4][2], const Unit& u, int wr, int wc, int fr, int fq) const {
#pragma unroll
        for (int ai = 0; ai < 2; ++ai)
#pragma unroll
            for (int m = 0; m < 4; ++m) {
                const int row = u.pm * 256 + ai * 128 + wr * 64 + m * 16 + fr;
                const float rstd = 1.0f / sqrtf(ssq[row] * (1.0f / DM) + RMS_EPS);
#pragma unroll
                for (int bj = 0; bj < 2; ++bj) {
                    f32x4 v0 = acc[ai][bj][m][0] * rstd, v1 = acc[ai][bj][m][1] * rstd;
#pragma unroll
                    for (int e = 0; e < 4; ++e) { const float a = fmaxf(v0[e], 0.f), b = fmaxf(v1[e], 0.f); v0[e] = a * a; v1[e] = b * b; }
                    u32x4 w; w.x = cvtpk(v0[0], v0[1]); w.y = cvtpk(v0[2], v0[3]); w.z = cvtpk(v1[0], v1[1]); w.w = cvtpk(v1[2], v1[3]);
                    *(u32x4*)(O + (size_t)row * FF + u.pn * 256 + bj * 128 + wc * 32 + 8 * fq) = w;
                }
            }
    }
};

struct EpiCrossSoftmax {
    static constexpr bool PERM = true, AFTER_DRAIN = true;
    const float* ssq; bf16* P;
    __device__ __forceinline__ void fused(f32x4 (&acc)[2][2][4][2], const Unit& u, int wr, int wc, int fr, int fq, LAS unsigned char* lds, int wid, int lane) const {
        LAS float* Pm = (LAS float*)lds; LAS float* Ps = (LAS float*)(lds + 4096);
#pragma unroll
        for (int ai = 0; ai < 2; ++ai)
#pragma unroll
            for (int m = 0; m < 4; ++m) {
                const int r = ai * 128 + wr * 64 + m * 16 + fr;
                const float rstd = LOG2E / sqrtf(ssq[u.pm * 256 + r] * (1.0f / DM) + RMS_EPS);
                float mx = -3.0e38f;
#pragma unroll
                for (int bj = 0; bj < 2; ++bj)
#pragma unroll
                    for (int n = 0; n < 2; ++n)
#pragma unroll
                        for (int e = 0; e < 4; ++e) { const float v = acc[ai][bj][m][n][e] * rstd; acc[ai][bj][m][n][e] = v; mx = fmaxf(mx, v); }
                mx = fmaxf(mx, __shfl_xor(mx, 16)); mx = fmaxf(mx, __shfl_xor(mx, 32));
                if (fq == 0) Pm[r * 4 + wc] = mx;
            }
        __syncthreads();
#pragma unroll
        for (int ai = 0; ai < 2; ++ai)
#pragma unroll
            for (int m = 0; m < 4; ++m) {
                const int r = ai * 128 + wr * 64 + m * 16 + fr;
                const f32x4 pm = *(const LAS f32x4*)(Pm + r * 4);
                const float M = fmaxf(fmaxf(pm[0], pm[1]), fmaxf(pm[2], pm[3]));
                float s = 0.f;
#pragma unroll
                for (int bj = 0; bj < 2; ++bj)
#pragma unroll
                    for (int n = 0; n < 2; ++n)
#pragma unroll
                        for (int e = 0; e < 4; ++e) { const float p = __builtin_amdgcn_exp2f(acc[ai][bj][m][n][e] - M); acc[ai][bj][m][n][e] = p; s += p; }
                s += __shfl_xor(s, 16); s += __shfl_xor(s, 32);
                if (fq == 0) Ps[r * 4 + wc] = s;
            }
        __syncthreads();
#pragma unroll
        for (int ai = 0; ai < 2; ++ai)
#pragma unroll
            for (int m = 0; m < 4; ++m) {
                const int r = ai * 128 + wr * 64 + m * 16 + fr;
                const f32x4 ps = *(const LAS f32x4*)(Ps + r * 4);
                const float inv = 1.0f / ((ps[0] + ps[1]) + (ps[2] + ps[3]));
#pragma unroll
                for (int bj = 0; bj < 2; ++bj) {
                    const f32x4 v0 = acc[ai][bj][m][0] * inv, v1 = acc[ai][bj][m][1] * inv;
                    u32x4 w; w.x = cvtpk(v0[0], v0[1]); w.y = cvtpk(v0[2], v0[3]); w.z = cvtpk(v1[0], v1[1]); w.w = cvtpk(v1[2], v1[3]);
                    *(u32x4*)(P + (size_t)(u.pm * 256 + r) * DM + u.pn * 256 + bj * 128 + wc * 32 + 8 * fq) = w;
                }
            }
        __syncthreads();
    }
};

struct EpiResFinal {
    static constexpr bool PERM = true, AFTER_DRAIN = true;
    const bf16* base; float* out; float* ssq; unsigned* cnt; const float* gfin;
    __device__ __forceinline__ void fused(f32x4 (&acc)[2][2][4][2], const Unit& u, int wr, int wc, int fr, int fq, LAS unsigned char* lds, int wid, int lane) const {
        const int col0 = u.pn * 256 + wc * 32 + 8 * fq;
#pragma unroll
        for (int ai = 0; ai < 2; ++ai)
#pragma unroll
            for (int m = 0; m < 4; ++m) {
                const int row = u.pm * 256 + ai * 128 + wr * 64 + m * 16 + fr; const size_t off = (size_t)row * DM + col0; float s = 0.f;
#pragma unroll
                for (int bj = 0; bj < 2; ++bj) {
                    const u32x4 w = *(const u32x4*)(base + off + bj * 128); u32x2 lo, hi; lo.x = w.x; lo.y = w.y; hi.x = w.z; hi.y = w.w;
                    const f32x4 o0 = bf4_to_f32(lo) + acc[ai][bj][m][0], o1 = bf4_to_f32(hi) + acc[ai][bj][m][1];
                    acc[ai][bj][m][0] = o0; acc[ai][bj][m][1] = o1;
                    s += ((o0[0] * o0[0] + o0[1] * o0[1]) + (o0[2] * o0[2] + o0[3] * o0[3])) + ((o1[0] * o1[0] + o1[1] * o1[1]) + (o1[2] * o1[2] + o1[3] * o1[3]));
                }
                s += __shfl_xor(s, 16); s += __shfl_xor(s, 32);
                if (fq == 0) atomicAdd(ssq + row, s);
            }
        asm volatile("s_waitcnt vmcnt(0)" ::: "memory");
        __syncthreads();
        if (threadIdx.x == 0) {
            __builtin_amdgcn_fence(__ATOMIC_RELEASE, "agent");
            asm volatile("s_waitcnt vmcnt(0)" ::: "memory");
            __hip_atomic_fetch_add(cnt + u.pm, 1u, __ATOMIC_RELAXED, __HIP_MEMORY_SCOPE_AGENT);
            unsigned sp = 0;
            while (__hip_atomic_load(cnt + u.pm, __ATOMIC_RELAXED, __HIP_MEMORY_SCOPE_AGENT) < 4u) { __builtin_amdgcn_s_sleep(1); if (++sp > (1u << 22)) break; }
            __builtin_amdgcn_fence(__ATOMIC_ACQUIRE, "agent");
        }
        __syncthreads();
#pragma unroll
        for (int ai = 0; ai < 2; ++ai)
#pragma unroll
            for (int m = 0; m < 4; ++m) {
                const int row = u.pm * 256 + ai * 128 + wr * 64 + m * 16 + fr; const size_t off = (size_t)row * DM + col0;
                const float rstd = 1.0f / sqrtf(__hip_atomic_load(ssq + row, __ATOMIC_RELAXED, __HIP_MEMORY_SCOPE_AGENT) * (1.0f / DM) + RMS_EPS);
#pragma unroll
                for (int bj = 0; bj < 2; ++bj)
#pragma unroll
                    for (int n = 0; n < 2; ++n) {
                        const f32x4 g = *(const f32x4*)(gfin + col0 + bj * 128 + 4 * n);
                        *(f32x4*)(out + off + bj * 128 + 4 * n) = acc[ai][bj][m][n] * rstd * g;
                    }
            }
    }
};

struct SmallOrder {
    int c0, nN, n, c;
    __device__ __forceinline__ bool next(int i, Unit& u) const { if (i) return false; const int L = c - c0; if (L < 0 || L >= n) return false; u.pm = L / nN; u.pn = L % nN; return true; }
    __device__ __forceinline__ void a_ready(const Unit&) const {}
    __device__ __forceinline__ void done(const Unit&) const {}
};

__device__ __forceinline__ void p0_transpose_item(const float* W, int K, int N, bf16* WT, const float* gain, LAS float* scr, int item, int lane) {
    const int nblk = N / 32, kb = item / nblk, nb = item % nblk, k0 = 64 * kb, n0 = 32 * nb;
#pragma unroll
    for (int i = 0; i < 8; ++i) {
        const int kk = 8 * i + (lane >> 3), nn = 4 * (lane & 7);
        f32x4 v = __builtin_nontemporal_load((const f32x4*)(W + (size_t)(k0 + kk) * N + n0 + nn)); if (gain) v = v * gain[k0 + kk];
        LAS float* d = scr + kk * 33 + nn; d[0] = v[0]; d[1] = v[1]; d[2] = v[2]; d[3] = v[3];
    }
    asm volatile("s_waitcnt lgkmcnt(0)" ::: "memory");
    const int c = lane & 7;
#pragma unroll
    for (int j = 0; j < 4; ++j) { const int n = (lane >> 3) + 8 * j; const LAS float* s = scr + (8 * c) * 33 + n;
        u32x4 o; o.x = cvtpk(s[0 * 33], s[1 * 33]); o.y = cvtpk(s[2 * 33], s[3 * 33]); o.z = cvtpk(s[4 * 33], s[5 * 33]); o.w = cvtpk(s[6 * 33], s[7 * 33]);
        *(u32x4*)(WT + (size_t)(n0 + n) * K + k0 + 8 * c) = o; }
    asm volatile("s_waitcnt lgkmcnt(0)" ::: "memory");
}
__device__ __forceinline__ void rms_row_to_bf16(const float* xrow, const float* g, bf16* orow, int lane) {
    const f32x4* xr = (const f32x4*)xrow + lane; const f32x4* gr = (const f32x4*)g + lane;
    f32x4 v[4]; float s = 0.f;
#pragma unroll
    for (int j = 0; j < 4; ++j) { v[j] = __builtin_nontemporal_load(xr + 64 * j); s += (v[j][0] * v[j][0] + v[j][1] * v[j][1]) + (v[j][2] * v[j][2] + v[j][3] * v[j][3]); }
    const float rstd = 1.0f / sqrtf(wave_sum(s) * (1.0f / DM) + RMS_EPS);
    u32x2* o8 = (u32x2*)orow + lane;
#pragma unroll
    for (int j = 0; j < 4; ++j) { const f32x4 gg = gr[64 * j]; u32x2 w; w.x = cvtpk(v[j][0] * rstd * gg[0], v[j][1] * rstd * gg[1]); w.y = cvtpk(v[j][2] * rstd * gg[2], v[j][3] * rstd * gg[3]); o8[64 * j] = w; }
}

__device__ __forceinline__ void row_to_bf16_rstd(const float* xrow, bf16* orow, float* rstd_out, int lane) {
    const f32x4* xr = (const f32x4*)xrow + lane;
    f32x4 v[4]; float s = 0.f;
#pragma unroll
    for (int j = 0; j < 4; ++j) { v[j] = __builtin_nontemporal_load(xr + 64 * j); s += (v[j][0] * v[j][0] + v[j][1] * v[j][1]) + (v[j][2] * v[j][2] + v[j][3] * v[j][3]); }
    s = wave_sum(s);
    if (lane == 0) *rstd_out = 1.0f / sqrtf(s * (1.0f / DM) + RMS_EPS);
    u32x2* o8 = (u32x2*)orow + lane;
#pragma unroll
    for (int j = 0; j < 4; ++j) { u32x2 w; w.x = cvtpk(v[j][0], v[j][1]); w.y = cvtpk(v[j][2], v[j][3]); o8[64 * j] = w; }
}

__device__ __forceinline__ void sb_wave_unit(int head, int qsub, const bf16* Qs, const bf16* Ks, const bf16* Vt, bf16* Y, int lane) {
    const int r32 = lane & 31, hi = lane >> 5;
    const int t0 = qsub * 32;
    const bf16* qp = Qs + ((size_t)head * SEQ + t0 + r32) * 64 + 8 * hi;
    bf16x8 qf[4];
#pragma unroll
    for (int s = 0; s < 4; ++s) qf[s] = *(const bf16x8*)(qp + 16 * s);
    f32x16 o0 = {}, o1 = {};
    float C = 0.f;
    const bf16* kbase = Ks + (size_t)head * SEQ * 64 + (size_t)r32 * 64 + 8 * hi;
    const bf16* vbase = Vt + (size_t)(512 + head * 64 + r32) * SEQ + 8 * hi;
    for (int kv0 = t0; kv0 >= 0; kv0 -= 32) {
        bf16x8 kf[4], vf0[2], vf1[2];
#pragma unroll
        for (int s = 0; s < 4; ++s) kf[s] = *(const bf16x8*)(kbase + (size_t)kv0 * 64 + 16 * s);
#pragma unroll
        for (int s = 0; s < 2; ++s) { vf0[s] = *(const bf16x8*)(vbase + kv0 + 16 * s); vf1[s] = *(const bf16x8*)(vbase + (size_t)32 * SEQ + kv0 + 16 * s); }
        f32x16 z = {};
#pragma unroll
        for (int s = 0; s < 4; ++s) z = __builtin_amdgcn_mfma_f32_32x32x16_bf16(kf[s], qf[s], z, 0, 0, 0);
        const bool diag = (kv0 == t0);
        float lm[16], sn[16];
#pragma unroll
        for (int r = 0; r < 16; ++r) {
            const float zz = z[r];
            const float e = __expf(-fabsf(zz));
            const float lp = __logf(1.0f + e);
            const bool valid = (!diag) || (crow(r, hi) < r32);
            lm[r] = valid ? -(fmaxf(zz, 0.f) + lp) : 0.f;
            sn[r] = valid ? (fmaxf(-zz, 0.f) + lp) : 1.0e30f;
        }
        float gs[4], ot[4], T[4];
#pragma unroll
        for (int G = 0; G < 4; ++G) { gs[G] = (lm[4 * G] + lm[4 * G + 1]) + (lm[4 * G + 2] + lm[4 * G + 3]); ot[G] = __shfl_xor(gs[G], 32); T[G] = gs[G] + ot[G]; }
        float sfx[4]; sfx[3] = 0.f; sfx[2] = T[3]; sfx[1] = T[3] + T[2]; sfx[0] = T[3] + T[2] + T[1];
        float a[16];
#pragma unroll
        for (int G = 0; G < 4; ++G) {
            const float off = C + sfx[G] + (hi == 0 ? ot[G] : 0.f);
            const float w2 = lm[4 * G + 3], w1 = w2 + lm[4 * G + 2], w0 = w1 + lm[4 * G + 1];
            a[4 * G + 3] = __expf(off - sn[4 * G + 3]);
            a[4 * G + 2] = __expf(off + w2 - sn[4 * G + 2]);
            a[4 * G + 1] = __expf(off + w1 - sn[4 * G + 1]);
            a[4 * G + 0] = __expf(off + w0 - sn[4 * G + 0]);
        }
        C += (T[0] + T[1]) + (T[2] + T[3]);
        u32x4 p0, p1;
        p0.x = cvtpk(a[0], a[1]); p0.y = cvtpk(a[2], a[3]); p0.z = cvtpk(a[4], a[5]); p0.w = cvtpk(a[6], a[7]);
        p1.x = cvtpk(a[8], a[9]); p1.y = cvtpk(a[10], a[11]); p1.z = cvtpk(a[12], a[13]); p1.w = cvtpk(a[14], a[15]);
        const bf16x8 pf0 = __builtin_bit_cast(bf16x8, p0), pf1 = __builtin_bit_cast(bf16x8, p1);
        o0 = __builtin_amdgcn_mfma_f32_32x32x16_bf16(vf0[0], pf0, o0, 0, 0, 0);
        o0 = __builtin_amdgcn_mfma_f32_32x32x16_bf16(vf0[1], pf1, o0, 0, 0, 0);
        o1 = __builtin_amdgcn_mfma_f32_32x32x16_bf16(vf1[0], pf0, o1, 0, 0, 0);
        o1 = __builtin_amdgcn_mfma_f32_32x32x16_bf16(vf1[1], pf1, o1, 0, 0, 0);
        if (__all(C < -100.0f)) break;
    }
    bf16* yp = Y + (size_t)(t0 + r32) * DM + 512 + head * 64 + 8 * hi;
#pragma unroll
    for (int p = 0; p < 2; ++p) {
        const int g = 2 * p;
        const unsigned a0x = cvtpk(o0[4 * g], o0[4 * g + 1]), a0y = cvtpk(o0[4 * g + 2], o0[4 * g + 3]), b0x = cvtpk(o0[4 * g + 4], o0[4 * g + 5]), b0y = cvtpk(o0[4 * g + 6], o0[4 * g + 7]);
        const unsigned a1x = cvtpk(o1[4 * g], o1[4 * g + 1]), a1y = cvtpk(o1[4 * g + 2], o1[4 * g + 3]), b1x = cvtpk(o1[4 * g + 4], o1[4 * g + 5]), b1y = cvtpk(o1[4 * g + 6], o1[4 * g + 7]);
        const auto r0x = __builtin_amdgcn_permlane32_swap(a0x, b0x, false, false), r0y = __builtin_amdgcn_permlane32_swap(a0y, b0y, false, false);
        const auto r1x = __builtin_amdgcn_permlane32_swap(a1x, b1x, false, false), r1y = __builtin_amdgcn_permlane32_swap(a1y, b1y, false, false);
        u32x4 w0, w1;
        w0.x = r0x[0]; w0.y = r0y[0]; w0.z = r0x[1]; w0.w = r0y[1];
        w1.x = r1x[0]; w1.y = r1y[0]; w1.z = r1x[1]; w1.w = r1y[1];
        *(u32x4*)(yp + 16 * p) = w0; *(u32x4*)(yp + 32 + 16 * p) = w1;
    }
}

constexpr int DA_PITCH = 128, DA_KB = 64 * DA_PITCH, DA_KBUF = 2 * DA_KB, DA_VB = 128 * DA_PITCH, DA_NSLOT = 3, DA_VOFF = DA_NSLOT * DA_KBUF, DA_QOFF = DA_VOFF + DA_NSLOT * DA_VB;
__device__ __forceinline__ float max3f(float a, float b, float c) { float r; asm volatile("v_max3_f32 %0, %1, %2, %3" : "=v"(r) : "v"(a), "v"(b), "v"(c)); return r; }
__device__ __forceinline__ float da_rowmax(f32x16& a, f32x16& b) {
    asm volatile("s_nop 15\n\ts_nop 7" : "+v"(a), "+v"(b));
    float m0 = max3f(a[0], a[1], a[2]), m1 = max3f(b[0], b[1], b[2]);
#pragma unroll
    for (int r = 3; r < 15; r += 2) { m0 = max3f(m0, a[r], a[r + 1]); m1 = max3f(m1, b[r], b[r + 1]); }
    float m = max3f(m0, m1, a[15]); m = max3f(m, b[15], b[15]);
    const auto rr = __builtin_amdgcn_permlane32_swap(__float_as_uint(m), __float_as_uint(m), false, false);
    return fmaxf(__uint_as_float(rr[0]), __uint_as_float(rr[1]));
}
__device__ __forceinline__ void da_mask(f32x16& s0, f32x16& s1, int kv0, int qrow, int hi) {
#pragma unroll
    for (int r = 0; r < 16; ++r) { const int kv = kv0 + crow(r, hi); if (kv > qrow) s0[r] = -1.0e30f; if (kv + 32 > qrow) s1[r] = -1.0e30f; }
}
template <bool DO_QK, bool DO_PV>
__device__ __forceinline__ void da_core(f32x16 (&o)[4], f32x16& s0, f32x16& s1, f32x16& n0, f32x16& n1, const f32x16& negm, const u32x4 (&pp)[4], float& l,
                                        const LAS unsigned char* qb, LAS unsigned char* kt, LAS unsigned char* vt, const int (&xo)[4]) {
    if (DO_QK) {
#pragma unroll
        for (int s = 0; s < 4; ++s) {
            const bf16x8 ka = *(const LAS bf16x8*)(kt + xo[s]), kb = *(const LAS bf16x8*)(kt + 32 * DA_PITCH + xo[s]);
            const bf16x8 qv = *(const LAS bf16x8*)(qb + s * 1024);
            n0 = __builtin_amdgcn_mfma_f32_32x32x16_bf16(ka, qv, s == 0 ? negm : n0, 0, 0, 0); n1 = __builtin_amdgcn_mfma_f32_32x32x16_bf16(kb, qv, s == 0 ? negm : n1, 0, 0, 0);
        }
    }
    if (DO_PV) {
#pragma unroll
        for (int db = 0; db < 4; ++db)
#pragma unroll
            for (int s = 0; s < 4; ++s) {
                const bf16x8 va = *(const LAS bf16x8*)(vt + db * 32 * DA_PITCH + xo[s]);
                o[db] = __builtin_amdgcn_mfma_f32_32x32x16_bf16(va, __builtin_bit_cast(bf16x8, pp[s]), o[db], 0, 0, 0);
            }
    }
    float ps = 0.f;
#pragma unroll
    for (int r = 0; r < 16; ++r) { s0[r] = __builtin_amdgcn_exp2f(s0[r]); s1[r] = __builtin_amdgcn_exp2f(s1[r]); ps += s0[r] + s1[r]; }
    l += ps;
}
struct DaDma { const bf16 *k0, *k1, *v0, *v1; size_t ko, vo; LAS unsigned char *kd, *vd; };
template <bool DMA_IN>
__device__ __forceinline__ void da_core_mid(f32x16 (&o)[4], f32x16& s0, f32x16& s1, f32x16& n0, f32x16& n1, const f32x16& negm, const u32x4 (&pp)[4], float& l,
                                            const LAS unsigned char* qb, LAS unsigned char* kt, LAS unsigned char* vt, const int (&xo)[4], float& mpart, const DaDma& dm) {
    bf16x8 fa[24], fq[4];
    float ps = 0.f, m0 = 0.f, m1 = 0.f;
#define DA_RD(j) do { if ((j) < 8) { fa[(j)] = *(const LAS bf16x8*)(kt + ((j) & 1) * 32 * DA_PITCH + xo[((j) >> 1) & 3]); if (((j) & 1) == 0) fq[((j) >> 1) & 3] = *(const LAS bf16x8*)(qb + (((j) >> 1) & 3) * 1024); } \
                      else { fa[(j)] = *(const LAS bf16x8*)(vt + (((j) - 8) & 3) * 32 * DA_PITCH + xo[(((j) - 8) >> 2) & 3]); } } while (0)
#define DA_EX(k) do { float a_; if ((k) & 1) { a_ = __builtin_amdgcn_exp2f(s1[(k) >> 1]); asm volatile("" : "+v"(a_)); s1[(k) >> 1] = a_; } else { a_ = __builtin_amdgcn_exp2f(s0[(k) >> 1]); asm volatile("" : "+v"(a_)); s0[(k) >> 1] = a_; } } while (0)
#define DA_AD(k) do { ps += ((k) & 1) ? s1[(k) >> 1] : s0[(k) >> 1]; } while (0)
    DA_RD(0); DA_RD(1); DA_RD(2); DA_RD(3);
    __builtin_amdgcn_s_setprio(1);
    __builtin_amdgcn_sched_barrier(0);
#pragma unroll
    for (int j = 0; j < 24; ++j) {
        if ((j & 3) == 0 && j + 4 < 24) { DA_RD(j + 4); DA_RD(j + 5); DA_RD(j + 6); DA_RD(j + 7); __builtin_amdgcn_sched_barrier(0); }
        if (j < 8) {
            const int sq = j >> 1;
            if ((j & 1) == 0) n0 = __builtin_amdgcn_mfma_f32_32x32x16_bf16(fa[j], fq[sq], sq == 0 ? negm : n0, 0, 0, 0);
            else              n1 = __builtin_amdgcn_mfma_f32_32x32x16_bf16(fa[j], fq[sq], sq == 0 ? negm : n1, 0, 0, 0);
        } else {
            const int sv = (j - 8) >> 2, db = (j - 8) & 3;
            o[db] = __builtin_amdgcn_mfma_f32_32x32x16_bf16(fa[j], __builtin_bit_cast(bf16x8, pp[sv]), o[db], 0, 0, 0);
        }
        const int k0 = (4 * j) / 3, k1 = (4 * (j + 1)) / 3;
#pragma unroll
        for (int k = 0; k < 32; ++k) if (k >= k0 && k < k1) DA_EX(k);
        if (j > 0) { const int a0 = (4 * (j - 1)) / 3, a1 = (4 * j) / 3;
#pragma unroll
            for (int k = 0; k < 32; ++k) if (k >= a0 && k < a1) DA_AD(k);
            asm volatile("" : "+v"(ps)); }
        if (DMA_IN) {
            if (j >= 1 && j <= 4) {
                const bf16* p = (j == 1) ? dm.k0 + dm.ko : (j == 2) ? dm.k1 + dm.ko : (j == 3) ? dm.v0 + dm.vo : dm.v1 + dm.vo;
                asm volatile("" : "+v"(p));
                LAS unsigned char* d = (j == 1) ? dm.kd : (j == 2) ? dm.kd + DA_KB : (j == 3) ? dm.vd : dm.vd + 8192;
                __builtin_amdgcn_global_load_lds((const unsigned*)p, (LAS unsigned*)d, 16, 0, 0);
            }
        }
        if (j == 12) { m0 = max3f(n0[0], n0[1], n0[2]); m1 = max3f(n1[0], n1[1], n1[2]); }
        if (j >= 13 && j <= 18) { const int r = 3 + 2 * (j - 13); m0 = max3f(m0, n0[r], n0[r + 1]); m1 = max3f(m1, n1[r], n1[r + 1]); }
        if (j == 19) { m0 = max3f(m0, m1, n0[15]); m0 = max3f(m0, n1[15], n1[15]); }
        __builtin_amdgcn_sched_barrier(0);
    }
    __builtin_amdgcn_s_setprio(0);
    mpart = m0;
    DA_AD(30); DA_AD(31);
#undef DA_RD
#undef DA_EX
#undef DA_AD
    l += ps;
}
__device__ __forceinline__ void da_pack(u32x4 (&pp)[4], const f32x16& s0, const f32x16& s1) {
    pp[0].x = cvtpk(s0[0], s0[1]); pp[0].y = cvtpk(s0[2], s0[3]); pp[0].z = cvtpk(s0[4], s0[5]); pp[0].w = cvtpk(s0[6], s0[7]);
    pp[1].x = cvtpk(s0[8], s0[9]); pp[1].y = cvtpk(s0[10], s0[11]); pp[1].z = cvtpk(s0[12], s0[13]); pp[1].w = cvtpk(s0[14], s0[15]);
    pp[2].x = cvtpk(s1[0], s1[1]); pp[2].y = cvtpk(s1[2], s1[3]); pp[2].z = cvtpk(s1[4], s1[5]); pp[2].w = cvtpk(s1[6], s1[7]);
    pp[3].x = cvtpk(s1[8], s1[9]); pp[3].y = cvtpk(s1[10], s1[11]); pp[3].z = cvtpk(s1[12], s1[13]); pp[3].w = cvtpk(s1[14], s1[15]);
}
__device__ __forceinline__ void da_tail(f32x16 (&o)[4], f32x16& s0, f32x16& s1, f32x16& n0, f32x16& n1, f32x16& negm, float& l, bool boundary, int kv0n, int qrow, int hi, bool have_part = false, float mpart = 0.f) {
    float mt;
    if (boundary || !have_part) { if (boundary) da_mask(n0, n1, kv0n, qrow, hi); mt = da_rowmax(n0, n1); }
    else { const auto rr = __builtin_amdgcn_permlane32_swap(__float_as_uint(mpart), __float_as_uint(mpart), false, false); mt = fmaxf(__uint_as_float(rr[0]), __uint_as_float(rr[1])); }
    if (__any(mt > 8.0f)) {
        const float d = fmaxf(mt, 0.f), alpha = __builtin_amdgcn_exp2f(-d);
#pragma unroll
        for (int r = 0; r < 16; ++r) { n0[r] -= d; n1[r] -= d; negm[r] -= d; s0[r] *= alpha; s1[r] *= alpha; }
#pragma unroll
        for (int db = 0; db < 4; ++db) o[db] *= alpha;
        l *= alpha;
        asm volatile("" : "+v"(negm));
    }
}
__device__ __forceinline__ void diff_unit(int h, int qb, const bf16* Qd, const bf16* Kd, const bf16* Vt, bf16* Y, const float* g_subln, float lam, LAS unsigned char* lds) {
    int tid = threadIdx.x; asm volatile("" : "+v"(tid));
    const int lane = tid & 63, wave = __builtin_amdgcn_readfirstlane(tid >> 6), r32 = lane & 31, hi = lane >> 5;
    const int comp = wave >> 2, wq = wave & 3;
    const int q0 = qb * 128, qrow = q0 + wq * 32 + r32;
    const bf16* qp = Qd + ((size_t)(2 * h + comp) * SEQ + qrow) * 64 + 8 * hi;
    LAS unsigned char* qfb = lds + DA_QOFF + wave * 4096 + lane * 16;
#pragma unroll
    for (int s = 0; s < 4; ++s) *(LAS bf16x8*)(qfb + s * 1024) = *(const bf16x8*)(qp + 16 * s);
    const int NT = (q0 + 128) / 64;
    const int prow = lane >> 3, pch = (lane & 7) ^ ((4 * wave + (lane >> 4)) & 7);
    const bf16* gk0 = Kd + ((size_t)(2 * h) * SEQ + 8 * wave + prow) * 64 + pch * 8;
    const bf16* gk1 = Kd + ((size_t)(2 * h + 1) * SEQ + 8 * wave + prow) * 64 + pch * 8;
    const bf16* gv0 = Vt + (size_t)(h * 128 + 8 * wave + prow) * SEQ + pch * 8;
    const bf16* gv1 = Vt + (size_t)(h * 128 + 64 + 8 * wave + prow) * SEQ + pch * 8;
    LAS unsigned char* ldw = lds + wave * 1024;
#define DA_DMA(gp, dst) __builtin_amdgcn_global_load_lds((const unsigned*)(gp), (LAS unsigned*)(dst), 16, 0, 0)
#define DA_WAITBAR() do { asm volatile("s_waitcnt vmcnt(0) lgkmcnt(0)" ::: "memory"); __builtin_amdgcn_s_barrier(); asm volatile("" ::: "memory"); } while (0)
    int xo[4];
#pragma unroll
    for (int s = 0; s < 4; ++s) xo[s] = ((2 * s + hi) ^ ((r32 >> 1) & 7)) * 16;
    LAS unsigned char* kfrag = lds + comp * DA_KB + r32 * DA_PITCH;
    LAS unsigned char* vfrag = lds + DA_VOFF + r32 * DA_PITCH;
#define DA_WAITBAR_N(N) do { asm volatile("s_waitcnt vmcnt(" #N ") lgkmcnt(0)" ::: "memory"); __builtin_amdgcn_s_barrier(); asm volatile("" ::: "memory"); } while (0)
    DA_DMA(gk0, ldw); DA_DMA(gk1, ldw + DA_KB); DA_DMA(gk0 + 64 * 64, ldw + DA_KBUF); DA_DMA(gk1 + 64 * 64, ldw + DA_KBUF + DA_KB);
    if (2 < NT) { DA_DMA(gk0 + (size_t)2 * 64 * 64, ldw + 2 * DA_KBUF); DA_DMA(gk1 + (size_t)2 * 64 * 64, ldw + 2 * DA_KBUF + DA_KB); }
    DA_DMA(gv0, ldw + DA_VOFF); DA_DMA(gv1, ldw + DA_VOFF + 8192);
    if (2 < NT) DA_WAITBAR_N(4); else DA_WAITBAR_N(2);
    f32x16 o[4]; o[0] = f32x16{}; o[1] = f32x16{}; o[2] = f32x16{}; o[3] = f32x16{};
    f32x16 s0, s1, n0 = {}, n1 = {}, negm = {};
    u32x4 pp[4] = {};
    float l = 0.f;
    {
        da_core<true, false>(o, n0, n1, s0, s1, negm, pp, l, qfb, kfrag, vfrag, xo);
        if (NT == 2) da_mask(s0, s1, 0, qrow, hi);
        const float m0 = da_rowmax(s0, s1);
#pragma unroll
        for (int r = 0; r < 16; ++r) { s0[r] -= m0; s1[r] -= m0; negm[r] = -m0; }
        asm volatile("" : "+v"(negm));
        l = 0.f;
    }
    int ks1 = DA_KBUF, ks3 = 0, vsm = 2 * DA_VB, vs1 = DA_VB;
#define DA_ROT() do { ks3 = ks1; ks1 = (ks1 == 2 * DA_KBUF) ? 0 : ks1 + DA_KBUF; vsm = (vsm == 2 * DA_VB) ? 0 : vsm + DA_VB; vs1 = (vs1 == 2 * DA_VB) ? 0 : vs1 + DA_VB; } while (0)
    {
        int nd = 0;
        asm volatile("s_waitcnt lgkmcnt(0)" ::: "memory"); __builtin_amdgcn_s_barrier(); asm volatile("" ::: "memory");
        if (3 < NT) { DA_DMA(gk0 + (size_t)3 * 64 * 64, ldw + ks3); DA_DMA(gk1 + (size_t)3 * 64 * 64, ldw + ks3 + DA_KB); nd += 2; }
        DA_DMA(gv0 + 64, ldw + DA_VOFF + vs1); DA_DMA(gv1 + 64, ldw + DA_VOFF + vs1 + 8192); nd += 2;
        da_core<true, false>(o, s0, s1, n0, n1, negm, pp, l, qfb, kfrag + ks1, vfrag, xo);
        da_tail(o, s0, s1, n0, n1, negm, l, 1 >= NT - 2, 64, qrow, hi);
        da_pack(pp, s0, s1); s0 = n0; s1 = n1;
        if (nd == 4) DA_WAITBAR_N(4); else DA_WAITBAR_N(2);
        DA_ROT();
    }
    int t = 1;
    for (; t + 4 < NT; t += 2) {
        {
            const size_t ko = (size_t)(t + 3) * 64 * 64;
            const DaDma dm{gk0, gk1, gv0, gv1, ko, (size_t)(t + 1) * 64, ldw + ks3, ldw + DA_VOFF + vs1};
            float mp;
            da_core_mid<true>(o, s0, s1, n0, n1, negm, pp, l, qfb, kfrag + ks1, vfrag + vsm, xo, mp, dm);
            da_tail(o, s0, s1, n0, n1, negm, l, false, 0, qrow, hi, true, mp);
            da_pack(pp, s0, s1);
            DA_WAITBAR_N(4);
            DA_ROT();
        }
        {
            const int u = t + 1;
            const size_t ko = (size_t)(u + 3) * 64 * 64;
            const DaDma dm{gk0, gk1, gv0, gv1, ko, (size_t)(u + 1) * 64, ldw + ks3, ldw + DA_VOFF + vs1};
            float mp;
            da_core_mid<true>(o, n0, n1, s0, s1, negm, pp, l, qfb, kfrag + ks1, vfrag + vsm, xo, mp, dm);
            da_tail(o, n0, n1, s0, s1, negm, l, false, 0, qrow, hi, true, mp);
            da_pack(pp, n0, n1);
            DA_WAITBAR_N(4);
            DA_ROT();
        }
    }
    for (; t < NT - 1; t += 2) {
        {
            int nd = 0;
            if (t + 3 < NT) { const size_t ko = (size_t)(t + 3) * 64 * 64; DA_DMA(gk0 + ko, ldw + ks3); DA_DMA(gk1 + ko, ldw + ks3 + DA_KB); nd += 2; }
            if (t + 1 < NT) { DA_DMA(gv0 + (size_t)(t + 1) * 64, ldw + DA_VOFF + vs1); DA_DMA(gv1 + (size_t)(t + 1) * 64, ldw + DA_VOFF + vs1 + 8192); nd += 2; }
            float mp;
            da_core_mid<false>(o, s0, s1, n0, n1, negm, pp, l, qfb, kfrag + ks1, vfrag + vsm, xo, mp, DaDma{});
            da_tail(o, s0, s1, n0, n1, negm, l, t + 1 >= NT - 2, (t + 1) * 64, qrow, hi, true, mp);
            da_pack(pp, s0, s1);
            if (nd == 4) DA_WAITBAR_N(4); else if (nd == 2) DA_WAITBAR_N(2); else DA_WAITBAR_N(0);
            DA_ROT();
        }
        {
            const int u = t + 1;
            int nd = 0;
            if (u + 3 < NT) { const size_t ko = (size_t)(u + 3) * 64 * 64; DA_DMA(gk0 + ko, ldw + ks3); DA_DMA(gk1 + ko, ldw + ks3 + DA_KB); nd += 2; }
            if (u + 1 < NT) { DA_DMA(gv0 + (size_t)(u + 1) * 64, ldw + DA_VOFF + vs1); DA_DMA(gv1 + (size_t)(u + 1) * 64, ldw + DA_VOFF + vs1 + 8192); nd += 2; }
            float mp;
            da_core_mid<false>(o, n0, n1, s0, s1, negm, pp, l, qfb, kfrag + ks1, vfrag + vsm, xo, mp, DaDma{});
            da_tail(o, n0, n1, s0, s1, negm, l, u + 1 >= NT - 2, (u + 1) * 64, qrow, hi, true, mp);
            da_pack(pp, n0, n1);
            if (nd == 4) DA_WAITBAR_N(4); else if (nd == 2) DA_WAITBAR_N(2); else DA_WAITBAR_N(0);
            DA_ROT();
        }
    }
    {
        da_core<false, true>(o, s0, s1, n0, n1, negm, pp, l, qfb, kfrag, vfrag + vsm, xo);
        da_pack(pp, s0, s1);
        DA_WAITBAR_N(0);
        const int vsl = (vsm == 2 * DA_VB) ? 0 : vsm + DA_VB;
        LAS unsigned char* vt = vfrag + vsl;
#pragma unroll
        for (int db = 0; db < 4; ++db)
#pragma unroll
            for (int s = 0; s < 4; ++s) {
                const bf16x8 va = *(const LAS bf16x8*)(vt + db * 32 * DA_PITCH + xo[s]);
                o[db] = __builtin_amdgcn_mfma_f32_32x32x16_bf16(va, __builtin_bit_cast(bf16x8, pp[s]), o[db], 0, 0, 0);
            }
    }
#undef DA_ROT
#undef DA_WAITBAR_N
#undef DA_DMA
    l += __shfl_xor(l, 32);
    const float inv = 1.0f / l;
    __syncthreads();
    LAS float* xb = (LAS float*)lds + (size_t)wq * 4096 + lane;
    if (comp == 1) {
#pragma unroll
        for (int db = 0; db < 4; ++db)
#pragma unroll
            for (int r = 0; r < 16; ++r) xb[(db * 16 + r) * 64] = o[db][r] * inv;
    }
    __syncthreads();
    if (comp == 0) {
        float ssq = 0.f;
#pragma unroll
        for (int db = 0; db < 4; ++db)
#pragma unroll
            for (int r = 0; r < 16; ++r) { const float d = o[db][r] * inv - lam * xb[(db * 16 + r) * 64]; o[db][r] = d; ssq += d * d; }
        ssq += __shfl_xor(ssq, 32);
        const float rstd = (1.0f - LAM_INIT) / sqrtf(ssq * (1.0f / 128.0f) + RMS_EPS);
        bf16* yp = Y + (size_t)qrow * DM + h * 128 + 4 * hi;
#pragma unroll
        for (int db = 0; db < 4; ++db)
#pragma unroll
            for (int g = 0; g < 4; ++g) {
                const f32x4 gg = *(const f32x4*)(g_subln + db * 32 + 8 * g + 4 * hi);
                u32x2 w; w.x = cvtpk(o[db][4 * g] * rstd * gg[0], o[db][4 * g + 1] * rstd * gg[1]); w.y = cvtpk(o[db][4 * g + 2] * rstd * gg[2], o[db][4 * g + 3] * rstd * gg[3]);
                *(u32x2*)(yp + db * 32 + 8 * g) = w;
            }
    }
    __syncthreads();
}

#define XB_TMO      128
#define XB_XCNT(j)  (256  + 64 * (j))
#define XB_XSUB(j)  (1280 + 64 * (j))
#define XB_XGEN(j)  (2304 + 64 * (j))
#define XB_TOP      3328
#define XB_TOPGEN   3392
#define XCD_BAR_WORDS 3456
#define XB_SPIN_CAP (1u << 18)

__device__ __forceinline__ unsigned xb_ld(unsigned* p)              { return __hip_atomic_load(p, __ATOMIC_RELAXED, __HIP_MEMORY_SCOPE_AGENT); }
__device__ __forceinline__ unsigned xb_add(unsigned* p, unsigned v) { return __hip_atomic_fetch_add(p, v, __ATOMIC_RELAXED, __HIP_MEMORY_SCOPE_AGENT); }
__device__ __forceinline__ unsigned xb_xcc_id() { return (unsigned)__builtin_amdgcn_s_getreg((3 << 11) | 20) & 0xFu; }
#define XB_SPIN(cond, bar) do { unsigned _sp = 0; while (cond) { __builtin_amdgcn_s_sleep(1); \
    if ((++_sp & 255u) == 0u) { if (xb_ld(&(bar)[XB_TMO])) break; if (_sp > XB_SPIN_CAP) { atomicAdd(&(bar)[XB_TMO], 1u); break; } } } } while (0)

struct XcdBarrier {
    unsigned* bar; unsigned x;
    volatile LAS unsigned* st;
};

__device__ __forceinline__ XcdBarrier xcd_barrier_post(unsigned* bar, volatile LAS unsigned* st) {
    XcdBarrier b; b.bar = bar; b.x = xb_xcc_id(); b.st = st;
    if (threadIdx.x == 0) (void)xb_add(&bar[XB_XCNT(b.x)], 1u);
    return b;
}
__device__ __forceinline__ void xcd_barrier_complete(unsigned* bar, unsigned x, unsigned& nloc, unsigned& nx) {
    const unsigned G = gridDim.x * gridDim.y * gridDim.z;
    unsigned sum, cnt, mine, sp = 0u;
    for (;;) {
        sum = 0u; cnt = 0u; mine = 0u;
#pragma unroll
        for (unsigned j = 0; j < 16; ++j) { const unsigned c = xb_ld(&bar[XB_XCNT(j)]); sum += c; cnt += (c > 0u) ? 1u : 0u; mine = (j == x) ? c : mine; }
        if (sum == G) break;
        __builtin_amdgcn_s_sleep(1);
        if ((++sp & 255u) == 0u) { if (xb_ld(&bar[XB_TMO])) break; if (sp > XB_SPIN_CAP) { atomicAdd(&bar[XB_TMO], 1u); break; } }
    }
    nloc = mine > 0u ? mine : 1u; nx = cnt > 0u ? cnt : 1u;
}

__device__ __forceinline__ void xcd_barrier(const XcdBarrier& b) {
    asm volatile("s_waitcnt vmcnt(0)" ::: "memory");
    __syncthreads();
    if (threadIdx.x == 0) {
        unsigned* bar = b.bar;
        __builtin_amdgcn_s_waitcnt(0);
        unsigned nloc = b.st[0], nx = b.st[1];
        if (nloc == 0u) { xcd_barrier_complete(bar, b.x, nloc, nx); b.st[0] = nloc; b.st[1] = nx; }
        const unsigned old = xb_add(&bar[XB_XSUB(b.x)], 1u);
        const unsigned gen = old / nloc;
        if (old + 1u == (gen + 1u) * nloc) {
            __builtin_amdgcn_fence(__ATOMIC_RELEASE, "agent");
            asm volatile("s_waitcnt vmcnt(0)" ::: "memory");
            const unsigned og = xb_add(&bar[XB_TOP], 1u);
            const unsigned tg = og / nx;
            if (og + 1u == (tg + 1u) * nx) xb_add(&bar[XB_TOPGEN], 1u);
            else XB_SPIN(xb_ld(&bar[XB_TOPGEN]) == tg, bar);
            __builtin_amdgcn_fence(__ATOMIC_ACQUIRE, "agent");
            xb_add(&bar[XB_XGEN(b.x)], 1u);
            asm volatile("s_waitcnt vmcnt(0)" ::: "memory");
        } else {
            XB_SPIN(xb_ld(&bar[XB_XGEN(b.x)]) == gen, bar);
            __builtin_amdgcn_fence(__ATOMIC_ACQUIRE, "agent");
            asm volatile("s_waitcnt vmcnt(0)" ::: "memory");
        }
    }
    __syncthreads();
}

#ifndef MK_N_LAUNCHES
#define MK_N_LAUNCHES 1
#endif
constexpr int N_PHASES = 9;
struct Args { const void* in[20]; float* out; unsigned char* ws; int ph_lo, ph_hi; };

__global__ void __launch_bounds__(512, 2) mega_fwd(Args args) {
    extern __shared__ __attribute__((aligned(16))) unsigned char lds_raw[];
    LAS unsigned char* lds = (LAS unsigned char*)lds_raw;
    cg::grid_group grid = cg::this_grid();
    const int G = gridDim.x, bx = blockIdx.x, NGW = G * 8;
#define PHASE_IDS int tid = threadIdx.x; asm volatile("" : "+v"(tid)); const int lane = tid & 63, wave = __builtin_amdgcn_readfirstlane(tid >> 6), gw = bx * 8 + wave; (void)lane; (void)gw;
    unsigned char* ws = args.ws;
    const float* x = (const float*)args.in[0]; const float* mem = (const float*)args.in[1]; const int* positions = (const int*)args.in[2];
    const float* g_mix = (const float*)args.in[3]; const float* w_in = (const float*)args.in[4];
    const float* lq1 = (const float*)args.in[5]; const float* lk1 = (const float*)args.in[6]; const float* lq2 = (const float*)args.in[7]; const float* lk2 = (const float*)args.in[8];
    const float* g_subln = (const float*)args.in[9]; const float* w_out = (const float*)args.in[10]; const float* g_cross = (const float*)args.in[11]; const float* g_mem = (const float*)args.in[12];
    const float* w_xq = (const float*)args.in[13]; const float* w_xkv = (const float*)args.in[14]; const float* w_xo = (const float*)args.in[15]; const float* g_mlp = (const float*)args.in[16];
    const float* w_up = (const float*)args.in[17]; const float* w_down = (const float*)args.in[18]; const float* g_final = (const float*)args.in[19];
    float* out = args.out;
    float* rstd0 = (float*)(ws + 196608); float* ssq1 = (float*)(ws + WS_SSQ1); float* ssq2 = (float*)(ws + WS_SSQ2); float* ssq3 = (float*)(ws + WS_SSQ3);
    float2* rope = (float2*)(ws + WS_ROPE);
    bf16* memn = (bf16*)(ws + WS_MEMN); bf16* kvb = (bf16*)(ws + WS_KV);
    bf16* Win_t = (bf16*)(ws + WS_WIN); bf16* Wout_t = (bf16*)(ws + WS_WOUT); bf16* Wxq_b = (bf16*)(ws + WS_WXQ); bf16* Wxkv_t = (bf16*)(ws + WS_WXKV); bf16* Wxo_t = (bf16*)(ws + WS_WXO);
    bf16* Wup_t = (bf16*)(ws + WS_WUP); bf16* Wdn_t = (bf16*)(ws + WS_WDN); bf16* Wqk_t = (bf16*)(ws + WS_WQK); bf16* Wvo_t = (bf16*)(ws + WS_WVO);
    bf16* XN = (bf16*)(ws + WS_XN); bf16* Pb = (bf16*)(ws + WS_P);
    bf16* Qd = (bf16*)(ws + WS_QD); bf16* Kd = (bf16*)(ws + WS_KD); bf16* Qs = (bf16*)(ws + WS_QS); bf16* Ks = (bf16*)(ws + WS_KS); bf16* Vt = (bf16*)(ws + WS_VT);
    bf16* Act = (bf16*)(ws + WS_ACT); bf16* Yb = (bf16*)(ws + WS_Y); bf16* H2b = (bf16*)(ws + WS_H2B); bf16* H1b = (bf16*)(ws + WS_H1B);

    const int lo = args.ph_lo, hi_ = args.ph_hi;
#define IN(k) (lo <= (k) && (k) < hi_)
    volatile LAS unsigned* bst = (volatile LAS unsigned*)(lds + 132096);
    if (threadIdx.x < 2) bst[threadIdx.x] = 0u;
    __syncthreads();
    XcdBarrier bar = xcd_barrier_post((unsigned*)(ws + WS_BAR), bst);
    if (lo < 0) grid.sync();
#define SEAM(k) do { if (IN(k) && IN((k) + 1)) xcd_barrier(bar); } while (0)

    if (IN(0)) {
        PHASE_IDS
        LAS float* scr = (LAS float*)(lds + wave * 16384);
        constexpr int I_IN = 16 * 96, I_OUT = 16 * 32, I_XKV = 16 * 64, I_XO = 16 * 32, I_UP = 16 * 128, I_DN = 64 * 32;
        for (int it = gw; it < I_XKV; it += NGW) p0_transpose_item(w_xkv, DM, 2 * DM, Wxkv_t, nullptr, scr, it, lane);
        for (int m = gw; m < MEML; m += NGW) rms_row_to_bf16(mem + (size_t)m * DM, g_mem, memn + (size_t)m * DM, lane);
        xcd_barrier(bar);
        const int NB = (G > 8) ? G - 8 : G;
        if (G > 8 && bx >= NB) {
            pg8::Gemm g{memn, Wxkv_t, MEML, 2 * DM, DM, DM, DM}; SmallOrder S{NB, 8, 8, bx};
            EpiPlain E{kvb, 2 * DM, 0, 0, nullptr, 1.0f};
            pg8::gemm_phase<EpiPlain, SmallOrder, true, true>(lds, g, S, E);
        }
        if (bx < NB) {
            const int gwl = bx * 8 + wave, NGWL = NB * 8;
            constexpr int NITEMS = I_IN + I_OUT + I_XO + I_UP + I_DN;
            for (int it = gwl; it < NITEMS; it += NGWL) {
                int r = it;
                if (r < I_IN) { p0_transpose_item(w_in, DM, INC, Win_t, g_mix, scr, r, lane); continue; } r -= I_IN;
                if (r < I_OUT) { p0_transpose_item(w_out, DM, DM, Wout_t, nullptr, scr, r, lane); continue; } r -= I_OUT;
                if (r < I_XO) { p0_transpose_item(w_xo, DM, DM, Wxo_t, nullptr, scr, r, lane); continue; } r -= I_XO;
                if (r < I_UP) { p0_transpose_item(w_up, DM, FF, Wup_t, g_mlp, scr, r, lane); continue; } r -= I_UP;
                p0_transpose_item(w_down, FF, DM, Wdn_t, nullptr, scr, r, lane);
            }
            const int gt = bx * 512 + tid, NGT = NB * 512;
            for (int i = gt; i < DM * DM / 4; i += NGT) { const f32x4 v = __builtin_nontemporal_load((const f32x4*)w_xq + i); u32x2 w; w.x = cvtpk(v[0], v[1]); w.y = cvtpk(v[2], v[3]); ((u32x2*)Wxq_b)[i] = w; }
            for (int i = gt; i < SEQ * 8; i += NGT) {
                const int row = i >> 3, k = i & 7;
                const float inv_freq = (float)pow(500000.0, -(double)k / 8.0);
                const float ang = (float)positions[row] * inv_freq;
                rope[i] = make_float2((float)cos((double)ang), (float)sin((double)ang));
            }
            for (int i = gt; i < SEQ; i += NGT) { ssq1[i] = 0.f; ssq2[i] = 0.f; ssq3[i] = 0.f; }
            for (int m = gwl; m < SEQ; m += NGWL) row_to_bf16_rstd(x + (size_t)m * DM, XN + (size_t)m * DM, rstd0 + m, lane);
        }
    }
    SEAM(0);
    if (IN(1)) {
        pg8::Gemm g{XN, Win_t, SEQ, INC, DM, DM, DM}; pg8::StaticOrder S; S.init(SEQ, INC, G, bx);
        EpiInProj E{Qd, Kd, Qs, Ks, Vt, rope, rstd0};
        pg8::gemm_phase<EpiInProj, pg8::StaticOrder, true, true>(lds, g, S, E);
    }
    SEAM(1);
    if (IN(2)) {
        PHASE_IDS
#pragma unroll 1
        for (int j = 0; j < 8; ++j) {
            const int hh = j & 3; const bool qk = j < 4;
            pg8::Gemm g{qk ? kvb + hh * 256 : Wxo_t + hh * 256, qk ? Wxq_b + hh * 256 : kvb + DM + hh * 256, qk ? 256 : DM, qk ? DM : 256, 256, qk ? 2 * DM : DM, qk ? DM : 2 * DM};
            SmallOrder S{4 * j, qk ? 4 : 1, 4, bx};
            EpiPlain E{qk ? Wqk_t : Wvo_t, DM, qk ? hh * 256 : 0, qk ? 0 : hh * 256, qk ? g_cross : nullptr, qk ? 0.0625f : 1.0f};
            pg8::gemm_phase<EpiPlain, SmallOrder, true, true>(lds, g, S, E);
        }
        for (int uu = gw; uu < 8 * (SEQ / 32); uu += NGW) sb_wave_unit(uu & 7, uu >> 3, Qs, Ks, Vt, Yb, lane);
        float lam;
        { const float a = wave_sum(lq1[lane] * lk1[lane]), b = wave_sum(lq2[lane] * lk2[lane]); lam = expf(a) - expf(b) + LAM_INIT; }
        __syncthreads();
        for (int p = bx; p < 256; p += G) {
            const int h = p & 3, pp = p >> 2;
#pragma unroll 1
            for (int k = 0; k < 2; ++k) diff_unit(h, k ? pp : 127 - pp, Qd, Kd, Vt, Yb, g_subln, lam, lds);
        }
    }
    SEAM(2);
    if (IN(3)) {
        pg8::Gemm g{Yb, Wout_t, SEQ, DM, DM, DM, DM}; pg8::StaticOrder S; S.init(SEQ, DM, G, bx);
        EpiRes<true> E{XN, H1b, ssq1};
        pg8::gemm_phase<EpiRes<true>, pg8::StaticOrder, true, true>(lds, g, S, E);
    }
    SEAM(3);
    if (IN(4)) {
        pg8::Gemm g{H1b, Wqk_t, SEQ, DM, DM, DM, DM}; pg8::StaticOrder S; S.init(SEQ, DM, G, bx);
        EpiCrossSoftmax E{ssq1, Pb};
        pg8::gemm_phase<EpiCrossSoftmax, pg8::StaticOrder, false, true>(lds, g, S, E);
    }
    SEAM(4);
    if (IN(5)) {
        pg8::Gemm g{Pb, Wvo_t, SEQ, DM, DM, DM, DM}; pg8::StaticOrder S; S.init(SEQ, DM, G, bx);
        EpiRes<true> E{H1b, H2b, ssq2};
        pg8::gemm_phase<EpiRes<true>, pg8::StaticOrder, true, true>(lds, g, S, E);
    }
    SEAM(5);
    if (IN(6)) {
        pg8::Gemm g{H2b, Wup_t, SEQ, FF, DM, DM, DM}; pg8::StaticOrder S; S.init(SEQ, FF, G, bx);
        EpiUp E{ssq2, Act};
        pg8::gemm_phase<EpiUp, pg8::StaticOrder, true, true>(lds, g, S, E);
    }
    SEAM(6);
    const bool fuse_final = (G == 256);
    if (IN(7)) {
        pg8::Gemm g{Act, Wdn_t, SEQ, DM, FF, FF, FF}; pg8::StaticOrder S; S.init(SEQ, DM, G, bx);
        if (fuse_final) {
            EpiResFinal E{H2b, out, ssq3, (unsigned*)(ws + WS_BAR + 14336), g_final};
            pg8::gemm_phase<EpiResFinal, pg8::StaticOrder, false, true>(lds, g, S, E);
        } else {
            EpiResF32 E{H2b, out, ssq3};
            pg8::gemm_phase<EpiResF32, pg8::StaticOrder, true, true>(lds, g, S, E);
        }
    }
    if (!fuse_final) {
        SEAM(7);
        if (IN(8)) {
            PHASE_IDS
            for (int m = gw; m < SEQ; m += NGW) {
                const float rstd = 1.0f / sqrtf(ssq3[m] * (1.0f / DM) + RMS_EPS);
                f32x4* orow = (f32x4*)(out + (size_t)m * DM) + lane; const f32x4* gr = (const f32x4*)g_final + lane;
#pragma unroll
                for (int j = 0; j < 4; ++j) { const f32x4 v = orow[64 * j]; orow[64 * j] = v * rstd * gr[64 * j]; }
            }
        }
    }
#undef IN
#undef SEAM
}

extern "C" void kernel_launch(void* const* d_in, const int* in_sizes, int n_in, void* d_out, int out_size, void* d_ws, size_t ws_size, hipStream_t stream) {
    static int grid = 0;
    if (grid == 0) {
        if (n_in != 20 || out_size != SEQ * DM || ws_size < WS_END) { fprintf(stderr, "kernel_launch: unexpected shapes (n_in %d out %d ws %zu)\n", n_in, out_size, ws_size); grid = -1; return; }
        int dev = 0, cus = 0, per_cu = 0;
        (void)hipGetDevice(&dev); (void)hipDeviceGetAttribute(&cus, hipDeviceAttributeMultiprocessorCount, dev);
        if (hipFuncSetAttribute((const void*)mega_fwd, hipFuncAttributeMaxDynamicSharedMemorySize, LDS_BYTES) != hipSuccess) { fprintf(stderr, "kernel_launch: hipFuncSetAttribute failed\n"); grid = -1; return; }
        if (hipOccupancyMaxActiveBlocksPerMultiprocessor(&per_cu, (const void*)mega_fwd, 512, LDS_BYTES) != hipSuccess || per_cu < 1) per_cu = 1;
        (void)hipGetLastError();
        grid = cus * per_cu;
        fprintf(stderr, "kernel_launch: grid %d (cus %d x %d)\n", grid, cus, per_cu);
    }
    if (grid < 0) return;
    Args a{};
    for (int i = 0; i < 20; ++i) a.in[i] = d_in[i];
    a.out = (float*)d_out; a.ws = (unsigned char*)d_ws;
#if MK_N_LAUNCHES == 1
    if (hipMemsetAsync((char*)d_ws + WS_BAR, 0, BAR_BYTES, stream) != hipSuccess) { fprintf(stderr, "kernel_launch: hipMemsetAsync failed\n"); return; }
    a.ph_lo = 0; a.ph_hi = N_PHASES;
    void* kargs[] = {&a};
    hipError_t e = hipLaunchCooperativeKernel((const void*)mega_fwd, dim3(grid), dim3(512), kargs, LDS_BYTES, stream);
    if (e != hipSuccess) fprintf(stderr, "cooperative launch failed: %s (grid %d)\n", hipGetErrorString(e), grid);
#else
    for (int p = 0; p < N_PHASES; ++p) { a.ph_lo = p; a.ph_hi = p + 1; hipLaunchKernelGGL(mega_fwd, dim3(grid), dim3(512), LDS_BYTES, stream, a); }
#endif
}
```
